# Optimizing an MI355X kernel written in HIP

```python
import jax, jax.numpy as jnp
from jax import lax
import numpy as np

D_MODEL = 1024
BATCH = 1
SEQ = 16384
DEPTH = 4

GRID_W = 64
CTX_LEN = 256

MLA_HEADS = 8
QK_NOPE = 64
QK_ROPE = 32
V_HEAD = 64
Q_LORA = 384
KV_LORA = 256
ROPE_BASE = 10000.0
Q_BLOCK = 128
MLA_SCALE = (QK_NOPE + QK_ROPE) ** -0.5

MLSTM_HEADS = 4
MQK = 64
MV = 128
CHUNK = 64
FGATE_BIAS_LO = 3.0
FGATE_BIAS_HI = 6.0

N_GROUPS = 4
EXPERTS_PER_GROUP = 8
N_EXPERTS = N_GROUPS * EXPERTS_PER_GROUP
TOP_K_IN_GROUP = 2
D_EXPERT = 256

DEEPNORM_ALPHA = (2 * DEPTH) ** 0.25
DEEPNORM_BETA = (8 * DEPTH) ** -0.25
LN_EPS = 1e-6

IN_SIZES = (Q_LORA, KV_LORA + QK_ROPE, MLSTM_HEADS * MQK, MLSTM_HEADS * MQK,
            MLSTM_HEADS * MV, MLSTM_HEADS * MV, 4 * MLSTM_HEADS, 2 * D_MODEL)
D_IN = sum(IN_SIZES)

F32 = jnp.float32

kernel_name = 'hybrid_mla_mlstm_hmoe_dit'


def layer_norm(x, g=None, b=None):
    xf = x.astype(F32)
    mu = xf.mean(-1, keepdims=True)
    var = jnp.square(xf - mu).mean(-1, keepdims=True)
    y = (xf - mu) * lax.rsqrt(var + LN_EPS)
    if g is not None:
        y = y * g + b
    return y.astype(x.dtype)


def rms_norm(x, g):
    xf = x.astype(F32)
    y = xf * lax.rsqrt(jnp.mean(xf * xf, -1, keepdims=True) + LN_EPS) * g
    return y.astype(x.dtype)


def modulate(x, shift, scale):
    return layer_norm(x) * (1 + scale) + shift


def rope_tables(rows):
    row, col = jnp.meshgrid(jnp.arange(rows, dtype=F32), jnp.arange(GRID_W, dtype=F32), indexing='ij')
    row, col = row.reshape(-1), col.reshape(-1)
    half = QK_ROPE // 2
    inv = ROPE_BASE ** (-jnp.arange(0, half, 2, dtype=F32) / half)
    ar, ac = row[:, None] * inv, col[:, None] * inv
    ang = jnp.concatenate([ar, ar, ac, ac], axis=-1)
    ang = jnp.concatenate([jnp.zeros((CTX_LEN, QK_ROPE), F32), ang], axis=0)
    return jnp.cos(ang), jnp.sin(ang)


def apply_rope(x, cos, sin):
    a1, a2, b1, b2 = jnp.split(x, 4, axis=-1)
    rot = jnp.concatenate([-a2, a1, -b2, b1], axis=-1)
    return (x * cos + rot * sin).astype(x.dtype)


def attend(qn, qr, kn, kr, v):
    s = jnp.einsum('bqhd,bkhd->bhqk', qn, kn) + jnp.einsum('bqhr,bkr->bhqk', qr, kr)
    p = jax.nn.softmax(s.astype(F32) * MLA_SCALE, axis=-1)
    return jnp.einsum('bhqk,bkhd->bqhd', p.astype(v.dtype), v)


def mla_branch(pqd, pkv, cos, sin, w_uq, w_uk, w_uv, g_qn, g_kvn):
    B, T, _ = pqd.shape
    S = T - CTX_LEN
    q = (rms_norm(pqd, g_qn) @ w_uq).reshape(B, T, MLA_HEADS, QK_NOPE + QK_ROPE)
    qn = q[..., :QK_NOPE]
    qr = apply_rope(q[..., QK_NOPE:], cos[:, None], sin[:, None])
    ckv = rms_norm(pkv[..., :KV_LORA], g_kvn)
    kr = apply_rope(pkv[..., KV_LORA:], cos, sin)
    kn = (ckv @ w_uk).reshape(B, T, MLA_HEADS, QK_NOPE)
    v = (ckv @ w_uv).reshape(B, T, MLA_HEADS, V_HEAD)
    oc = attend(qn[:, :CTX_LEN], qr[:, :CTX_LEN], kn[:, :CTX_LEN], kr[:, :CTX_LEN], v[:, :CTX_LEN])
    nb = S // Q_BLOCK

    def blocks(a):
        return jnp.moveaxis(a[:, CTX_LEN:].reshape(B, nb, Q_BLOCK, *a.shape[2:]), 1, 0)

    ol = lax.map(lambda qs: attend(qs[0], qs[1], kn, kr, v), (blocks(qn), blocks(qr)))
    ol = jnp.moveaxis(ol, 0, 1).reshape(B, S, MLA_HEADS * V_HEAD)
    return jnp.concatenate([oc.reshape(B, CTX_LEN, MLA_HEADS * V_HEAD), ol], axis=1)


def mlstm_chunked(q, k, v, ig, lf, state):
    B, H, T, _ = q.shape
    nc = T // CHUNK

    def chunks(a):
        return jnp.moveaxis(a.reshape(B, H, nc, CHUNK, *a.shape[3:]), 2, 0)

    tril = jnp.tril(jnp.ones((CHUNK, CHUNK), bool))

    def step(carry, xs):
        C, n, m = carry
        qc, kc, vc, ic, fc = xs
        b = jnp.cumsum(fc, axis=-1)
        dlog = jnp.where(tril, b[..., :, None] - b[..., None, :] + ic[..., None, :], -jnp.inf)
        inter = b + m[..., None]
        mj = jnp.maximum(inter, dlog.max(-1))
        w = jnp.exp(dlog - mj[..., None])
        sc = jnp.exp(inter - mj)
        qk = jnp.einsum('bhjd,bhsd->bhjs', qc, kc) * w
        num = jnp.einsum('bhjs,bhsv->bhjv', qk, vc) + sc[..., None] * jnp.einsum('bhjd,bhdv->bhjv', qc, C)
        nq = qk.sum(-1) + sc * jnp.einsum('bhjd,bhd->bhj', qc, n)
        h = num / jnp.maximum(jnp.abs(nq), jnp.exp(-mj))[..., None]
        bl = b[..., -1]
        wlog = bl[..., None] - b + ic
        m_new = jnp.maximum(bl + m, wlog.max(-1))
        ws = jnp.exp(wlog - m_new[..., None])
        sd = jnp.exp(bl + m - m_new)
        C_new = sd[..., None, None] * C + jnp.einsum('bhs,bhsd,bhsv->bhdv', ws, kc, vc)
        n_new = sd[..., None] * n + jnp.einsum('bhs,bhsd->bhd', ws, kc)
        return (C_new, n_new, m_new), h

    state, h = lax.scan(step, state, tuple(chunks(a) for a in (q, k, v, ig, lf)))
    return jnp.moveaxis(h, 0, 2).reshape(B, H, T, MV), state


def mlstm_branch(pq, pk, pv, po, pg, b_gates, g_mh):
    B, T, _ = pq.shape

    def heads(a):
        return jnp.moveaxis(a.reshape(B, T, MLSTM_HEADS, -1), 1, 2).astype(F32)

    q = heads(pq) * MQK ** -0.5
    k = heads(pk)
    v = heads(pv)
    gates = jnp.moveaxis((pg.astype(F32) + b_gates.astype(F32)).reshape(B, T, 4, MLSTM_HEADS), 1, 3)
    zero = (jnp.zeros((B, MLSTM_HEADS, MQK, MV), F32),
            jnp.zeros((B, MLSTM_HEADS, MQK), F32),
            jnp.zeros((B, MLSTM_HEADS), F32))

    def direction(ig, f_pre, reverse):
        lf = jax.nn.log_sigmoid(f_pre)

        def seg(a, lo, hi):
            a = a[:, :, lo:hi]
            return jnp.flip(a, axis=2) if reverse else a

        args = (q, k, v, ig, lf)
        hc, st = mlstm_chunked(*(seg(a, 0, CTX_LEN) for a in args), zero)
        hl, _ = mlstm_chunked(*(seg(a, CTX_LEN, T) for a in args), st)
        if reverse:
            hc, hl = jnp.flip(hc, axis=2), jnp.flip(hl, axis=2)
        return jnp.concatenate([hc, hl], axis=2)

    h = direction(gates[:, 0], gates[:, 1], False) + direction(gates[:, 2], gates[:, 3], True)
    h = layer_norm(h) * g_mh.reshape(MLSTM_HEADS, 1, MV)
    h = jnp.moveaxis(h, 1, 2).reshape(B, T, MLSTM_HEADS * MV)
    return (h * jax.nn.sigmoid(po.astype(F32))).astype(pq.dtype)


def token_mixer(hc, hl, cos, sin, w_in, b_gates, w_uq, w_uk, w_uv, g_qn, g_kvn, g_mh,
                w_bo_mla, w_bo_mlstm, w_out):
    h = jnp.concatenate([hc, hl], axis=1)
    p = h @ w_in
    pqd, pkv, pq, pk, pv, po, pg, pm = jnp.split(p, np.cumsum(IN_SIZES)[:-1].tolist(), axis=-1)
    y_mla = mla_branch(pqd, pkv, cos, sin, w_uq, w_uk, w_uv, g_qn, g_kvn) @ w_bo_mla
    y_mlstm = mlstm_branch(pq, pk, pv, po, pg, b_gates, g_mh) @ w_bo_mlstm
    g_a, g_b = jnp.split(jax.nn.sigmoid(pm), 2, axis=-1)
    y = (g_a * y_mla + g_b * y_mlstm) @ w_out
    return y[:, :CTX_LEN], y[:, CTX_LEN:]


def hier_moe(h, w_rg, b_rg, w_re, b_re, w_e_gate, w_e_up, w_e_down):
    B, N, _ = h.shape
    lg = (h @ w_rg + b_rg).astype(F32)
    grp = jnp.argmax(lg, axis=-1)
    p_grp = jnp.take_along_axis(jax.nn.softmax(lg, axis=-1), grp[..., None], axis=-1)
    le = (h @ w_re + b_re).astype(F32).reshape(B, N, N_GROUPS, EXPERTS_PER_GROUP)
    le = jnp.take_along_axis(le, grp[..., None, None], axis=2)[..., 0, :]
    w_top, i_top = lax.top_k(jax.nn.softmax(le, axis=-1), TOP_K_IN_GROUP)
    w_top = w_top / w_top.sum(-1, keepdims=True) * p_grp
    eid = grp[..., None] * EXPERTS_PER_GROUP + i_top
    comb = jnp.einsum('bnk,bnke->bne', w_top, jax.nn.one_hot(eid, N_EXPERTS, dtype=F32))
    y = jnp.zeros_like(h)
    for g in range(N_GROUPS):
        sl = slice(g * EXPERTS_PER_GROUP, (g + 1) * EXPERTS_PER_GROUP)
        a = jnp.einsum('bnd,edf->bnef', h, w_e_gate[sl])
        u = jnp.einsum('bnd,edf->bnef', h, w_e_up[sl])
        hid = jax.nn.silu(a) * u * comb[..., sl, None].astype(h.dtype)
        y = y + jnp.einsum('bnef,efd->bnd', hid, w_e_down[sl])
    return y


def setup_inputs(seed: int = 0) -> dict:
    key = jax.random.key(seed)
    ks = iter(jax.random.split(key, 40))
    L, D = DEPTH, D_MODEL

    def nrm(shape, scale):
        return jax.random.normal(next(ks), shape, F32) * scale

    def gain(shape):
        return 1.0 + nrm(shape, 0.05)

    fg = jnp.linspace(FGATE_BIAS_LO, FGATE_BIAS_HI, MLSTM_HEADS, dtype=F32)
    b_gates = jnp.concatenate([nrm((L, MLSTM_HEADS), 0.1), fg + nrm((L, MLSTM_HEADS), 0.1),
                               nrm((L, MLSTM_HEADS), 0.1), fg + nrm((L, MLSTM_HEADS), 0.1)], axis=-1)
    return {
        'x': nrm((BATCH, SEQ, D), 1.0),
        'c': nrm((BATCH, D), 1.0),
        'ctx': nrm((BATCH, CTX_LEN, D), 1.0),
        'c_ctx': nrm((D,), 1.0),
        'w_ada': nrm((L, D, 6 * D), D ** -0.5),
        'b_ada': nrm((L, 6 * D), 0.1),
        'w_in': nrm((L, D, D_IN), D ** -0.5),
        'b_gates': b_gates,
        'w_uq': nrm((L, Q_LORA, MLA_HEADS * (QK_NOPE + QK_ROPE)), Q_LORA ** -0.5),
        'w_uk': nrm((L, KV_LORA, MLA_HEADS * QK_NOPE), KV_LORA ** -0.5),
        'w_uv': nrm((L, KV_LORA, MLA_HEADS * V_HEAD), KV_LORA ** -0.5),
        'g_qn': gain((L, Q_LORA)),
        'g_kvn': gain((L, KV_LORA)),
        'g_mh': gain((L, MLSTM_HEADS * MV)),
        'w_bo_mla': nrm((L, MLA_HEADS * V_HEAD, D), (MLA_HEADS * V_HEAD) ** -0.5 * DEEPNORM_BETA),
        'w_bo_mlstm': nrm((L, MLSTM_HEADS * MV, D), (MLSTM_HEADS * MV) ** -0.5 * DEEPNORM_BETA),
        'w_out': nrm((L, D, D), D ** -0.5 * DEEPNORM_BETA),
        'ln1_g': gain((L, D)),
        'ln1_b': nrm((L, D), 0.02),
        'w_rg': nrm((L, D, N_GROUPS), D ** -0.5),
        'b_rg': nrm((L, N_GROUPS), 0.01),
        'w_re': nrm((L, D, N_EXPERTS), D ** -0.5),
        'b_re': nrm((L, N_EXPERTS), 0.01),
        'w_e_gate': nrm((L, N_EXPERTS, D, D_EXPERT), D ** -0.5),
        'w_e_up': nrm((L, N_EXPERTS, D, D_EXPERT), D ** -0.5),
        'w_e_down': nrm((L, N_EXPERTS, D_EXPERT, D), D_EXPERT ** -0.5 * DEEPNORM_BETA),
        'ln2_g': gain((L, D)),
        'ln2_b': nrm((L, D), 0.02),
    }


def reference(x, c, ctx, c_ctx, w_ada, b_ada, w_in, b_gates, w_uq, w_uk, w_uv, g_qn, g_kvn, g_mh,
              w_bo_mla, w_bo_mlstm, w_out, ln1_g, ln1_b, w_rg, b_rg, w_re, b_re,
              w_e_gate, w_e_up, w_e_down, ln2_g, ln2_b):
    ROWS = x.shape[1] // GRID_W
    cos, sin = rope_tables(ROWS)
    xl, xc = x, ctx
    s_lat, s_ctx = jax.nn.silu(c), jax.nn.silu(c_ctx)
    for l in range(DEPTH):
        last = l == DEPTH - 1
        sh1l, sc1l, g1l, sh2l, sc2l, g2l = [m[:, None, :] for m in jnp.split(s_lat @ w_ada[l] + b_ada[l], 6, axis=-1)]
        sh1c, sc1c, g1c, sh2c, sc2c, g2c = jnp.split(s_ctx @ w_ada[l] + b_ada[l], 6, axis=-1)
        yc, yl = token_mixer(modulate(xc, sh1c, sc1c), modulate(xl, sh1l, sc1l), cos, sin,
                             w_in[l], b_gates[l], w_uq[l], w_uk[l], w_uv[l], g_qn[l], g_kvn[l], g_mh[l],
                             w_bo_mla[l], w_bo_mlstm[l], w_out[l])
        xl = layer_norm(DEEPNORM_ALPHA * xl + g1l * yl, ln1_g[l], ln1_b[l])
        moe_args = (w_rg[l], b_rg[l], w_re[l], b_re[l], w_e_gate[l], w_e_up[l], w_e_down[l])
        if not last:
            xc = layer_norm(DEEPNORM_ALPHA * xc + g1c * yc, ln1_g[l], ln1_b[l])
            xc = layer_norm(DEEPNORM_ALPHA * xc + g2c * hier_moe(modulate(xc, sh2c, sc2c), *moe_args),
                            ln2_g[l], ln2_b[l])
        xl = layer_norm(DEEPNORM_ALPHA * xl + g2l * hier_moe(modulate(xl, sh2l, sc2l), *moe_args),
                        ln2_g[l], ln2_b[l])
    return xl
```

```cpp
#ifndef EMU
#include <hip/hip_runtime.h>
#include <cstdio>
#include <cstdint>
#include <cstring>
#endif

#ifndef SEQ
#define SEQ 16384
#endif
#ifndef CTX
#define CTX 256
#endif
#ifndef DEPTH
#define DEPTH 4
#endif
#ifndef PROBE_DUP
#define PROBE_DUP -1
#endif
#ifndef ATTN_BIG
#define ATTN_BIG 1099511627776.f
#endif
#ifndef ATTN_REFHI
#define ATTN_REFHI 40.f
#endif
#define ATTN_REFLO -100.f
#ifndef N_LAUNCH_MODE
#define N_LAUNCH_MODE 0
#endif

#define DI __device__ __forceinline__
typedef unsigned short bf16_t;
typedef short bf16x8 __attribute__((ext_vector_type(8)));
typedef short bf16x4 __attribute__((ext_vector_type(4)));
typedef float f32x4 __attribute__((ext_vector_type(4)));
typedef float f32x16 __attribute__((ext_vector_type(16)));
typedef unsigned u32x4 __attribute__((ext_vector_type(4)));
typedef unsigned u32x2 __attribute__((ext_vector_type(2)));

#ifndef EMU
#define SMEM_DECL extern __shared__ __attribute__((aligned(16))) unsigned char smem[];
#define MFMA16(a, b, c) __builtin_amdgcn_mfma_f32_16x16x32_bf16((a), (b), (c), 0, 0, 0)
#define MFMA32(a, b, c) __builtin_amdgcn_mfma_f32_32x32x16_bf16((a), (b), (c), 0, 0, 0)
#define SHFL(v, s) __shfl((v), (s))
#define SHFL_XOR(v, m) __shfl_xor((v), (m))
#define SHFL_UP(v, d) __shfl_up((v), (d))
#define EXP2F(x) __builtin_amdgcn_exp2f(x)
#define RCPF(x) __builtin_amdgcn_rcpf(x)
#define WAVE_SYNC() __builtin_amdgcn_wave_barrier()
#define WAVE_ANY(p) (__any((int)(p)) != 0)
#define GLDS16(gptr, ldsptr) __builtin_amdgcn_global_load_lds((const unsigned*)(gptr), (unsigned __attribute__((address_space(3)))*)(ldsptr), 16, 0, 0)
#define WAIT_VM0() asm volatile("s_waitcnt vmcnt(0)" ::: "memory")
#define NOSLP(x) asm("" : "+v"(x))
#else
#define SMEM_DECL unsigned char* smem = emu::lds();
#define MFMA16(a, b, c) emu_mfma16((a), (b), (c))
#define MFMA32(a, b, c) emu_mfma32((a), (b), (c))
#define SHFL(v, s) emu_shfl((v), (s))
#define SHFL_XOR(v, m) emu_shfl_xor((v), (m))
#define SHFL_UP(v, d) emu_shfl_up((v), (d))
#define EXP2F(x) exp2f(x)
#define RCPF(x) (1.0f / (x))
#define WAVE_SYNC() emu::wave_sync(emu::wav())
#define WAVE_ANY(p) emu_any((int)(p))
#define GLDS16(gptr, ldsptr) memcpy((unsigned char*)(ldsptr) + 16 * (threadIdx.x & 63), (gptr), 16)
#define WAIT_VM0() do {} while (0)
#define NOSLP(x) do {} while (0)
#define __expf(x) expf(x)
#endif

constexpr int D = 1024, T = CTX + SEQ, NB = T / 64, NCB = CTX / 64, RT = T / 128, ROWS = SEQ / 64;
constexpr int DIN = 4272, DINP = 4352;
constexpr int C_PQD = 0, C_PKV = 384, C_KR = 640, C_PQ = 672, C_PK = 928, C_PV = 1184, C_PO = 1696, C_PG = 2208, C_PM = 2224;
constexpr float LN_EPS = 1e-6f;
constexpr float ALPHA = 1.6817928305074290f;
constexpr float QSCALE = 0.10206207261596575f * 1.4426950408889634f;
constexpr int NPH = 10;
constexpr int NPHASE_TOTAL = 2 + DEPTH * NPH;
constexpr int LDS_BYTES = 73728;
constexpr int TH = 160, MIH = TH / 32;
constexpr int TR = (T % 160 == 0) ? 160 : 128, MIT = TR / 32, RTT = T / TR;
constexpr int NTHREADS = 256;

constexpr size_t al256(size_t x) { return (x + 255) & ~(size_t)255; }
constexpr size_t WS_BAR = 0;
constexpr size_t WS_CNT = 16384;
constexpr size_t WS_ZERO_BYTES = 16384 + 65536;
constexpr size_t WS_MOD = WS_ZERO_BYTES;
constexpr size_t WS_ROPE = al256(WS_MOD + (size_t)DEPTH * 2 * 6144 * 4);
constexpr size_t WS_ROUT = al256(WS_ROPE + ((size_t)ROWS * 16 + 1024) * 4);
constexpr size_t WS_WIN = al256(WS_ROUT + (size_t)DEPTH * 2 * 48 * 1024 * 2);
constexpr size_t WS_WUQ = al256(WS_WIN + (size_t)DEPTH * DINP * 1024 * 2);
constexpr size_t WS_WKV = al256(WS_WUQ + (size_t)DEPTH * 768 * 384 * 2);
constexpr size_t WS_WBO = al256(WS_WKV + (size_t)DEPTH * 1024 * 256 * 2);
constexpr size_t WS_WOUT = al256(WS_WBO + (size_t)DEPTH * 1024 * 1024 * 2);
constexpr size_t WS_WGU = al256(WS_WOUT + (size_t)DEPTH * 1024 * 1024 * 2);
constexpr size_t WS_WD = al256(WS_WGU + (size_t)32 * 512 * 1024 * 2);
constexpr size_t WS_X = al256(WS_WD + (size_t)32 * 1024 * 256 * 2);
constexpr size_t WS_HN = al256(WS_X + (size_t)T * 1024 * 4);
constexpr size_t WS_P = al256(WS_HN + (size_t)T * 1024 * 2);
constexpr size_t WS_ZB = WS_P;
constexpr size_t WS_MOE = WS_P;
constexpr size_t WS_HID = al256(WS_P + (size_t)T * DINP * 2);
constexpr size_t WS_GATES = al256(WS_HID + (size_t)(2 * T + 32 * TH) * 256 * 2);
constexpr size_t WS_SSQ = al256(WS_GATES + (size_t)T * 16 * 4);
constexpr size_t WS_QB = al256(WS_SSQ + (size_t)T * 16 * 4);
constexpr size_t WS_KB = al256(WS_QB + (size_t)T * 768 * 2);
constexpr size_t WS_U = WS_QB;
constexpr size_t WS_VT = al256(WS_KB + (size_t)T * 768 * 2);
constexpr size_t WS_PKT = al256(WS_VT + (size_t)512 * T * 2);
constexpr size_t WS_PVT = al256(WS_PKT + (size_t)256 * T * 2);
constexpr size_t WS_O = al256(WS_PVT + (size_t)512 * T * 2);
constexpr size_t WS_HM = al256(WS_O + (size_t)T * 512 * 2);
constexpr size_t WS_CLOC = al256(WS_HM + (size_t)T * 512 * 2);
constexpr size_t WS_NLOC = al256(WS_CLOC + (size_t)8 * NB * 8192 * 4);
constexpr size_t WS_BLA = al256(WS_NLOC + (size_t)8 * NB * 64 * 4);
constexpr size_t WS_CPREV = al256(WS_BLA + (size_t)8 * NB * 2 * 4);
constexpr size_t WS_NPREV = al256(WS_CPREV + (size_t)8 * NB * 8192 * 2);
constexpr size_t WS_MPREV = al256(WS_NPREV + (size_t)8 * NB * 64 * 4);
constexpr size_t WS_LIST = al256(WS_MPREV + (size_t)8 * NB * 4);
constexpr size_t WS_LISTW = al256(WS_LIST + (size_t)32 * T * 4);
constexpr size_t WS_END = al256(WS_LISTW + (size_t)32 * T * 4);

struct Params {
    const float *x, *c, *ctx, *c_ctx, *w_ada, *b_ada, *w_in, *b_gates, *w_uq, *w_uk, *w_uv, *g_qn, *g_kvn, *g_mh, *w_bo_mla, *w_bo_mlstm, *w_out, *ln1_g, *ln1_b,
        *w_rg, *b_rg, *w_re, *b_re, *w_e_gate, *w_e_up, *w_e_down, *ln2_g, *ln2_b;
    float* out; unsigned char* ws;
    int ph_lo, ph_hi;
};

#ifndef EMU
DI int otid() { int t = threadIdx.x; asm volatile("" : "+v"(t)); return t; }
DI unsigned char* optr(unsigned char* q) { asm volatile("" : "+s"(q)); return q; }
DI int oint(int v) { asm volatile("" : "+s"(v)); return v; }
#else
DI int otid() { return threadIdx.x; }
DI unsigned char* optr(unsigned char* q) { return q; }
DI int oint(int v) { return v; }
#endif
DI float bf2f(bf16_t h) { return __builtin_bit_cast(float, (unsigned)h << 16); }
DI bf16_t f2bf(float f) { unsigned u = __builtin_bit_cast(unsigned, f); u += 0x7fffu + ((u >> 16) & 1u); return (bf16_t)(u >> 16); }
#ifndef EMU
typedef __bf16 bf16x2_hw __attribute__((ext_vector_type(2)));
typedef float f32x2_hw __attribute__((ext_vector_type(2)));
#endif
DI unsigned pack2(float lo, float hi) {
#ifndef EMU
    const f32x2_hw v = {lo, hi}; return __builtin_bit_cast(unsigned, __builtin_convertvector(v, bf16x2_hw));
#else
    return (unsigned)f2bf(lo) | ((unsigned)f2bf(hi) << 16);
#endif
}
DI u32x2 pack4(f32x4 v) { u32x2 r; r.x = pack2(v[0], v[1]); r.y = pack2(v[2], v[3]); return r; }
DI unsigned pack2h(float lo, float hi) { return (unsigned)__builtin_bit_cast(unsigned short, (_Float16)lo) | ((unsigned)__builtin_bit_cast(unsigned short, (_Float16)hi) << 16); }
DI u32x2 pack4h(f32x4 v) { u32x2 r; r.x = pack2h(v[0], v[1]); r.y = pack2h(v[2], v[3]); return r; }
DI float h2f(unsigned short h) { return (float)__builtin_bit_cast(_Float16, h); }
DI f32x4 unpack4h(u32x2 w) { f32x4 r; r[0] = h2f((unsigned short)(w.x & 0xffff)); r[1] = h2f((unsigned short)(w.x >> 16)); r[2] = h2f((unsigned short)(w.y & 0xffff)); r[3] = h2f((unsigned short)(w.y >> 16)); return r; }
DI f32x4 quad_transpose(f32x4 v, int lane) {
    const bool b1 = lane & 2, b0 = lane & 1;
    { const float a0 = b1 ? v[0] : v[2], a1 = b1 ? v[1] : v[3]; const float r0 = SHFL_XOR(a0, 2), r1 = SHFL_XOR(a1, 2); if (b1) { v[0] = r0; v[1] = r1; } else { v[2] = r0; v[3] = r1; } }
    { const float a0 = b0 ? v[0] : v[1], a1 = b0 ? v[2] : v[3]; const float r0 = SHFL_XOR(a0, 1), r1 = SHFL_XOR(a1, 1); if (b0) { v[0] = r0; v[2] = r1; } else { v[1] = r0; v[3] = r1; } }
    return v;
}
DI u32x4 widen_pair(u32x2 a, u32x2 b, int lane) {
#ifndef EMU
    const u32x2 r0 = __builtin_amdgcn_permlane16_swap(a.x, b.x, false, false), r1 = __builtin_amdgcn_permlane16_swap(a.y, b.y, false, false);
    return (u32x4){r0[0], r1[0], r0[1], r1[1]};
#else
    const bool odd = (lane >> 4) & 1;
    const unsigned sx = odd ? a.x : b.x, sy = odd ? a.y : b.y, rx = SHFL_XOR(sx, 16), ry = SHFL_XOR(sy, 16);
    if (odd) { a.x = rx; a.y = ry; } else { b.x = rx; b.y = ry; }
    return (u32x4){a.x, a.y, b.x, b.y};
#endif
}
DI int widen_col(int ni, int lane) { const int fq = lane >> 4; return (fq & 1) ? (ni + 1) * 16 + 4 * (fq - 1) : ni * 16 + 4 * fq; }
DI float wave_sum(float v) { v += SHFL_XOR(v, 32); v += SHFL_XOR(v, 16); v += SHFL_XOR(v, 8); v += SHFL_XOR(v, 4); v += SHFL_XOR(v, 2); v += SHFL_XOR(v, 1); return v; }
DI float wave_max(float v) { v = fmaxf(v, SHFL_XOR(v, 32)); v = fmaxf(v, SHFL_XOR(v, 16)); v = fmaxf(v, SHFL_XOR(v, 8)); v = fmaxf(v, SHFL_XOR(v, 4)); v = fmaxf(v, SHFL_XOR(v, 2)); v = fmaxf(v, SHFL_XOR(v, 1)); return v; }
DI float scan_sum(float v, int lane) {
#pragma unroll
    for (int d = 1; d < 64; d <<= 1) { float t = SHFL_UP(v, d); if (lane >= d) v += t; } return v; }
DI float scan_max(float v, int lane) {
#pragma unroll
    for (int d = 1; d < 64; d <<= 1) { float t = SHFL_UP(v, d); if (lane >= d) v = fmaxf(v, t); } return v; }
DI float sigmoidf_(float x) { return RCPF(1.0f + EXP2F(-1.4426950408889634f * x)); }
DI float siluf_(float x) { return x * RCPF(1.0f + EXP2F(-1.4426950408889634f * x)); }
DI float logsigmoidf_(float x) { return fminf(x, 0.f) - log1pf(__expf(-fabsf(x))); }
DI int crow(int r, int hh) { return (r & 3) + 8 * (r >> 2) + 4 * hh; }

#ifndef EMU
#define XB_TMO      128
#define XB_XCNT(j)  (256  + 64 * (j))
#define XB_XSUB(j)  (1280 + 64 * (j))
#define XB_XGEN(j)  (2304 + 64 * (j))
#define XB_TOP      3328
#define XB_TOPGEN   3392
#define XCD_BAR_WORDS 3456
#define XB_SPIN_CAP (1u << 22)
#define LAS __attribute__((address_space(3)))
__device__ __forceinline__ unsigned xb_ld(unsigned* p)              { return __hip_atomic_load(p, __ATOMIC_RELAXED, __HIP_MEMORY_SCOPE_AGENT); }
__device__ __forceinline__ unsigned xb_add(unsigned* p, unsigned v) { return __hip_atomic_fetch_add(p, v, __ATOMIC_RELAXED, __HIP_MEMORY_SCOPE_AGENT); }
__device__ __forceinline__ unsigned xb_xcc_id() { return (unsigned)__builtin_amdgcn_s_getreg((3 << 11) | 20) & 0xFu; }
#define XB_SPIN(cond, bar) do { unsigned _sp = 0; while (cond) { __builtin_amdgcn_s_sleep(1); \
    if ((++_sp & 255u) == 0u) { if (xb_ld(&(bar)[XB_TMO])) break; if (_sp > XB_SPIN_CAP) { atomicAdd(&(bar)[XB_TMO], 1u); break; } } } } while (0)
struct XcdBarrier { unsigned* bar; unsigned x; volatile LAS unsigned* st; };
__device__ __forceinline__ XcdBarrier xcd_barrier_post(unsigned* bar, volatile LAS unsigned* st) {
    XcdBarrier b; b.bar = bar; b.x = xb_xcc_id(); b.st = st;
    if (threadIdx.x == 0) (void)xb_add(&bar[XB_XCNT(b.x)], 1u);
    return b;
}
__device__ __forceinline__ void xcd_barrier_complete(unsigned* bar, unsigned x, unsigned& nloc, unsigned& nx) {
    const unsigned G = gridDim.x * gridDim.y * gridDim.z;
    unsigned sum, cnt, mine, sp = 0u;
    for (;;) {
        sum = 0u; cnt = 0u; mine = 0u;
#pragma unroll
        for (unsigned j = 0; j < 16; ++j) { const unsigned c = xb_ld(&bar[XB_XCNT(j)]); sum += c; cnt += (c > 0u) ? 1u : 0u; mine = (j == x) ? c : mine; }
        if (sum == G) break;
        __builtin_amdgcn_s_sleep(1);
        if ((++sp & 255u) == 0u) { if (xb_ld(&bar[XB_TMO])) break; if (sp > XB_SPIN_CAP) { atomicAdd(&bar[XB_TMO], 1u); break; } }
    }
    nloc = mine > 0u ? mine : 1u; nx = cnt > 0u ? cnt : 1u;
}
__device__ __forceinline__ void xcd_barrier(const XcdBarrier& b) {
    asm volatile("s_waitcnt vmcnt(0)" ::: "memory");
    __syncthreads();
    if (threadIdx.x == 0) {
        unsigned* bar = b.bar;
        __builtin_amdgcn_s_waitcnt(0);
        unsigned nloc = b.st[0], nx = b.st[1];
        if (nloc == 0u) { xcd_barrier_complete(bar, b.x, nloc, nx); b.st[0] = nloc; b.st[1] = nx; }
        const unsigned old = xb_add(&bar[XB_XSUB(b.x)], 1u);
        const unsigned gen = old / nloc;
        if (old + 1u == (gen + 1u) * nloc) {
            __builtin_amdgcn_fence(__ATOMIC_RELEASE, "agent");
            asm volatile("s_waitcnt vmcnt(0)" ::: "memory");
            const unsigned og = xb_add(&bar[XB_TOP], 1u);
            const unsigned tg = og / nx;
            if (og + 1u == (tg + 1u) * nx) xb_add(&bar[XB_TOPGEN], 1u);
            else XB_SPIN(xb_ld(&bar[XB_TOPGEN]) == tg, bar);
            __builtin_amdgcn_fence(__ATOMIC_ACQUIRE, "agent");
            xb_add(&bar[XB_XGEN(b.x)], 1u);
            asm volatile("s_waitcnt vmcnt(0)" ::: "memory");
        } else {
            XB_SPIN(xb_ld(&bar[XB_XGEN(b.x)]) == gen, bar);
            __builtin_amdgcn_fence(__ATOMIC_ACQUIRE, "agent");
            asm volatile("s_waitcnt vmcnt(0)" ::: "memory");
        }
    }
    __syncthreads();
}
#endif

struct RowsPlain { const bf16_t* base; long ld; DI const bf16_t* row(int r) const { return base + (long)r * ld; } };
struct RowsGather { const bf16_t* base; const int* list; int n; DI const bf16_t* row(int r) const { const int tok = (r < n) ? (list[r] >> 1) : 0; return base + (long)tok * 1024; } };

DI float sumsq8(u32x4 v) {
    float a0 = bf2f((bf16_t)(v.x & 0xffff)), a1 = bf2f((bf16_t)(v.x >> 16)), a2 = bf2f((bf16_t)(v.y & 0xffff)), a3 = bf2f((bf16_t)(v.y >> 16));
    float a4 = bf2f((bf16_t)(v.z & 0xffff)), a5 = bf2f((bf16_t)(v.z >> 16)), a6 = bf2f((bf16_t)(v.w & 0xffff)), a7 = bf2f((bf16_t)(v.w >> 16));
    return ((a0 * a0 + a1 * a1) + (a2 * a2 + a3 * a3)) + ((a4 * a4 + a5 * a5) + (a6 * a6 + a7 * a7));
}
template <bool STATS, class AR, int MI>
DI void gemm_main(f32x4 (&acc)[MI][4], float (&ss)[4], const AR& ar, const bf16_t* __restrict__ Bt, long ldb, int K, unsigned char* smem) {
    constexpr int ABYTES = 4096 * MI, STAGE = ABYTES + 16384;
    const int tid = otid(), lane = tid & 63, wave = tid >> 6, wr = wave >> 1, wc = wave & 1;
    const bf16_t* ap[MI]; const bf16_t* bp[4];
#pragma unroll
    for (int i = 0; i < MI; ++i) { const int pos = (wave * MI + i) * 64 + lane, row = pos >> 3, c = (pos & 7) ^ ((row >> 1) & 7); ap[i] = ar.row(row) + c * 8; }
#pragma unroll
    for (int i = 0; i < 4; ++i) { const int pos = (wave * 4 + i) * 64 + lane, row = pos >> 3, c = (pos & 7) ^ ((row >> 1) & 7); bp[i] = Bt + (long)row * ldb + c * 8; }
#define GEMM_ISSUE(KT, BUF) do { unsigned char* base_ = smem + (BUF) * STAGE; \
        _Pragma("unroll") for (int i = 0; i < MI; ++i) GLDS16(ap[i] + (KT) * 64, base_ + (wave * MI + i) * 1024); \
        _Pragma("unroll") for (int i = 0; i < 4; ++i) GLDS16(bp[i] + (KT) * 64, base_ + ABYTES + (wave * 4 + i) * 1024); } while (0)
    GEMM_ISSUE(0, 0);
    const int nk = K >> 6;
    const int fr = lane & 15, fq = lane >> 4, sw = (fr >> 1) & 7;
    for (int kt = 0; kt < nk; ++kt) {
        WAIT_VM0(); __syncthreads();
        if (kt + 1 < nk) GEMM_ISSUE(kt + 1, (kt + 1) & 1);
        const bf16_t* As = (const bf16_t*)(smem + (kt & 1) * STAGE); const bf16_t* Bs = As + ABYTES / 2;
#pragma unroll
        for (int ks = 0; ks < 2; ++ks) {
            bf16x8 a[MI], b[4];
#pragma unroll
            for (int i = 0; i < MI; ++i) a[i] = *(const bf16x8*)(As + (wr * 16 * MI + i * 16 + fr) * 64 + ((ks * 4 + fq) ^ sw) * 8);
#pragma unroll
            for (int i = 0; i < 4; ++i) b[i] = *(const bf16x8*)(Bs + (wc * 64 + i * 16 + fr) * 64 + ((ks * 4 + fq) ^ sw) * 8);
#pragma unroll
            for (int mi = 0; mi < MI; ++mi)
#pragma unroll
                for (int ni = 0; ni < 4; ++ni) acc[mi][ni] = MFMA16(b[ni], a[mi], acc[mi][ni]);
        }
    }
    __syncthreads();
#undef GEMM_ISSUE
}
template <class AR, int MI>
DI void gemm_chain(f32x4 (&acc)[MI][4], const AR& ar, const bf16_t* __restrict__ Bt, long ldb, int K, unsigned char* smem,
                   bool pre, bool has_next, const AR& nar, const bf16_t* __restrict__ nBt, long nldb) {
    constexpr int ABYTES = 4096 * MI, STAGE = ABYTES + 16384;
    const int tid = otid(), lane = tid & 63, wave = tid >> 6, wr = wave >> 1, wc = wave & 1;
    const bf16_t* ap[MI]; const bf16_t* bp[4];
#pragma unroll
    for (int i = 0; i < MI; ++i) { const int pos = (wave * MI + i) * 64 + lane, row = pos >> 3, c = (pos & 7) ^ ((row >> 1) & 7); ap[i] = ar.row(row) + c * 8; }
#pragma unroll
    for (int i = 0; i < 4; ++i) { const int pos = (wave * 4 + i) * 64 + lane, row = pos >> 3, c = (pos & 7) ^ ((row >> 1) & 7); bp[i] = Bt + (long)row * ldb + c * 8; }
#define GEMM_ISSUE(KT, BUF) do { unsigned char* base_ = smem + (BUF) * STAGE; \
        _Pragma("unroll") for (int i = 0; i < MI; ++i) GLDS16(ap[i] + (KT) * 64, base_ + (wave * MI + i) * 1024); \
        _Pragma("unroll") for (int i = 0; i < 4; ++i) GLDS16(bp[i] + (KT) * 64, base_ + ABYTES + (wave * 4 + i) * 1024); } while (0)
    if (!pre) GEMM_ISSUE(0, 0);
    const int nk = K >> 6;
    const int fr = lane & 15, fq = lane >> 4, sw = (fr >> 1) & 7;
    for (int kt = 0; kt < nk; ++kt) {
        WAIT_VM0(); __syncthreads();
        if (kt + 1 < nk) GEMM_ISSUE(kt + 1, (kt + 1) & 1);
        else if (has_next) {
#pragma unroll
            for (int i = 0; i < MI; ++i) { const int pos = (wave * MI + i) * 64 + lane, row = pos >> 3, c = (pos & 7) ^ ((row >> 1) & 7); ap[i] = nar.row(row) + c * 8; }
#pragma unroll
            for (int i = 0; i < 4; ++i) { const int pos = (wave * 4 + i) * 64 + lane, row = pos >> 3, c = (pos & 7) ^ ((row >> 1) & 7); bp[i] = nBt + (long)row * nldb + c * 8; }
            GEMM_ISSUE(0, 0);
        }
        const bf16_t* As = (const bf16_t*)(smem + (kt & 1) * STAGE); const bf16_t* Bs = As + ABYTES / 2;
#pragma unroll
        for (int ks = 0; ks < 2; ++ks) {
            bf16x8 a[MI], b[4];
#pragma unroll
            for (int i = 0; i < MI; ++i) a[i] = *(const bf16x8*)(As + (wr * 16 * MI + i * 16 + fr) * 64 + ((ks * 4 + fq) ^ sw) * 8);
#pragma unroll
            for (int i = 0; i < 4; ++i) b[i] = *(const bf16x8*)(Bs + (wc * 64 + i * 16 + fr) * 64 + ((ks * 4 + fq) ^ sw) * 8);
#pragma unroll
            for (int mi = 0; mi < MI; ++mi)
#pragma unroll
                for (int ni = 0; ni < 4; ++ni) acc[mi][ni] = MFMA16(b[ni], a[mi], acc[mi][ni]);
        }
    }
    __syncthreads();
#undef GEMM_ISSUE
}
template <int MI>
DI void acc_zero(f32x4 (&acc)[MI][4]) {
#pragma unroll
    for (int i = 0; i < MI; ++i)
#pragma unroll
        for (int j = 0; j < 4; ++j) acc[i][j] = (f32x4){0.f, 0.f, 0.f, 0.f};
}

template <class MAP>
DI void transpose_tile(const float* __restrict__ src, int ld_src, int C, int r0, int c0, bf16_t* __restrict__ dst, int ld_dst, int dst_col0, const float* g, const MAP& map, unsigned char* smem) {
    float* s = (float*)smem;
    const int tid = otid();
#pragma unroll
    for (int i = 0; i < 4; ++i) {
        const int id = tid + 256 * i, r = id >> 4, c4 = (id & 15) * 4;
        f32x4 v = (f32x4){0.f, 0.f, 0.f, 0.f};
        if (c0 + c4 < C) v = *(const f32x4*)(src + (long)(r0 + r) * ld_src + c0 + c4);
        const float gs = g ? g[r0 + r] : 1.0f;
        s[r * 65 + c4 + 0] = v[0] * gs; s[r * 65 + c4 + 1] = v[1] * gs; s[r * 65 + c4 + 2] = v[2] * gs; s[r * 65 + c4 + 3] = v[3] * gs;
    }
    __syncthreads();
#pragma unroll
    for (int i = 0; i < 2; ++i) {
        const int id = tid + 256 * i, c = id >> 3, r8 = (id & 7) * 8;
        u32x4 w;
        w.x = pack2(s[(r8 + 0) * 65 + c], s[(r8 + 1) * 65 + c]); w.y = pack2(s[(r8 + 2) * 65 + c], s[(r8 + 3) * 65 + c]);
        w.z = pack2(s[(r8 + 4) * 65 + c], s[(r8 + 5) * 65 + c]); w.w = pack2(s[(r8 + 6) * 65 + c], s[(r8 + 7) * 65 + c]);
        *(u32x4*)(dst + (long)map(c0 + c) * ld_dst + dst_col0 + r0 + r8) = w;
    }
    __syncthreads();
}
struct MapId { DI int operator()(int c) const { return c; } };
struct MapOff { int off; DI int operator()(int c) const { return c + off; } };
struct MapGU { int up; DI int operator()(int c) const { return 32 * (c >> 4) + 16 * up + (c & 15); } };

DI void row_stats(const f32x4 (&v)[4], float& mean, float& rstd) {
    float s = 0.f;
#pragma unroll
    for (int i = 0; i < 4; ++i) s += (v[i][0] + v[i][1]) + (v[i][2] + v[i][3]);
    s = wave_sum(s); mean = s * (1.0f / 1024.0f);
    float q = 0.f;
#pragma unroll
    for (int i = 0; i < 4; ++i) { const f32x4 d = v[i] - mean; q += (d[0] * d[0] + d[1] * d[1]) + (d[2] * d[2] + d[3] * d[3]); }
    q = wave_sum(q); rstd = 1.0f / sqrtf(q * (1.0f / 1024.0f) + LN_EPS);
}

DI bool xcd_unit(int it, int NRT, int NCT, int& rt, int& ct) {
    const int G = gridDim.x;
    if (G & 7) { const int u = blockIdx.x + it * G; if (u >= NRT * NCT) return false; rt = u / NCT; ct = u - rt * NCT; return true; }
    const int nx = G >> 3, x = blockIdx.x & 7, j = blockIdx.x >> 3;
    const int NRTm = NRT & ~7, Lx = (NRTm >> 3) * NCT;
    const int v = j + it * nx;
    if (v < Lx) { const int i = v / NCT; ct = v - i * NCT; rt = x + 8 * i; return true; }
    int nmain = (Lx - j + nx - 1) / nx; if (nmain < 0) nmain = 0;
    const int w = x + 8 * ((j - Lx % nx + nx) % nx) + (it - nmain) * G;
    if (w >= (NRT - NRTm) * NCT) return false;
    const int i = w / NCT; rt = NRTm + i; ct = w - i * NCT; return true;
}

DI void phase_p0(const Params& p, unsigned char* smem) {
    unsigned char* ws = optr(p.ws);
    constexpr int U_WIN = 16 * 68, U_WUQ = 6 * 12, U_WK = 4 * 8, U_WV = 4 * 8, U_BOA = 8 * 16, U_BOB = 8 * 16, U_WOUT = 16 * 16, U_ADA = 96, U_ROUT = 48, U_ROPE = ((ROWS + 64) * 8 + NTHREADS - 1) / NTHREADS;
    constexpr int U_LAYER = U_WIN + U_WUQ + U_WK + U_WV + U_BOA + U_BOB + U_WOUT + U_ADA + U_ROUT;
    const int total = U_LAYER * DEPTH + U_ROPE;
    const int tid = otid();
    for (int u = blockIdx.x; u < total; u += gridDim.x) {
        if (u >= U_LAYER * DEPTH) {
            float* tab = (float*)(ws + WS_ROPE);
            for (int i = (u - U_LAYER * DEPTH) * NTHREADS + tid; i < (ROWS + 64) * 8; i += U_ROPE * NTHREADS) {
                const int pos = i >> 3, j = i & 7; const bool isrow = pos < ROWS; const int pv = isrow ? pos : pos - ROWS;
                const float inv = powf(10000.0f, -(float)(2 * j) / 16.0f);
                const float ang = (float)pv * inv;
                const double a = (double)ang;
                const float cs = (float)cos(a), sn = (float)sin(a);
                if (isrow) { tab[pv * 8 + j] = cs; tab[ROWS * 8 + pv * 8 + j] = sn; } else { tab[ROWS * 16 + pv * 8 + j] = cs; tab[ROWS * 16 + 512 + pv * 8 + j] = sn; }
            }
            continue;
        }
        const int l = u / U_LAYER; int v = u % U_LAYER;
        if (v < U_WIN) { transpose_tile(p.w_in + (size_t)l * 1024 * DIN, DIN, DIN, (v / 68) * 64, (v % 68) * 64, (bf16_t*)(ws + WS_WIN) + (size_t)l * DINP * 1024, 1024, 0, nullptr, MapId(), smem); continue; }
        v -= U_WIN;
        if (v < U_WUQ) { transpose_tile(p.w_uq + (size_t)l * 384 * 768, 768, 768, (v / 12) * 64, (v % 12) * 64, (bf16_t*)(ws + WS_WUQ) + (size_t)l * 768 * 384, 384, 0, p.g_qn + l * 384, MapId(), smem); continue; }
        v -= U_WUQ;
        if (v < U_WK) { transpose_tile(p.w_uk + (size_t)l * 256 * 512, 512, 512, (v / 8) * 64, (v % 8) * 64, (bf16_t*)(ws + WS_WKV) + (size_t)l * 1024 * 256, 256, 0, p.g_kvn + l * 256, MapId(), smem); continue; }
        v -= U_WK;
        if (v < U_WV) { transpose_tile(p.w_uv + (size_t)l * 256 * 512, 512, 512, (v / 8) * 64, (v % 8) * 64, (bf16_t*)(ws + WS_WKV) + (size_t)l * 1024 * 256, 256, 0, p.g_kvn + l * 256, MapOff{512}, smem); continue; }
        v -= U_WV;
        if (v < U_BOA) { transpose_tile(p.w_bo_mla + (size_t)l * 512 * 1024, 1024, 1024, (v / 16) * 64, (v % 16) * 64, (bf16_t*)(ws + WS_WBO) + (size_t)l * 1024 * 1024, 1024, 0, nullptr, MapId(), smem); continue; }
        v -= U_BOA;
        if (v < U_BOB) { transpose_tile(p.w_bo_mlstm + (size_t)l * 512 * 1024, 1024, 1024, (v / 16) * 64, (v % 16) * 64, (bf16_t*)(ws + WS_WBO) + (size_t)l * 1024 * 1024, 1024, 512, nullptr, MapId(), smem); continue; }
        v -= U_BOB;
        if (v < U_WOUT) { transpose_tile(p.w_out + (size_t)l * 1024 * 1024, 1024, 1024, (v / 16) * 64, (v % 16) * 64, (bf16_t*)(ws + WS_WOUT) + (size_t)l * 1024 * 1024, 1024, 0, nullptr, MapId(), smem); continue; }
        v -= U_WOUT;
        if (v < U_ADA) {
            const int lane = tid & 63, wave = tid >> 6, cg = lane & 15, kp = wave * 4 + (lane >> 4), col = v * 64 + cg * 4;
            const float* W = p.w_ada + (size_t)l * 1024 * 6144 + col;
            f32x4 al = (f32x4){0.f, 0.f, 0.f, 0.f}, ac = al;
#pragma unroll 16
            for (int k = kp * 64; k < kp * 64 + 64; ++k) {
                const f32x4 w = *(const f32x4*)(W + (size_t)k * 6144);
                const float sl = siluf_(p.c[k]), sc = siluf_(p.c_ctx[k]);
                al += w * sl; ac += w * sc;
            }
            f32x4* red = (f32x4*)smem;
            red[(kp * 2 + 0) * 16 + cg] = al; red[(kp * 2 + 1) * 16 + cg] = ac;
            __syncthreads();
            if (tid < 32) {
                const int s_ = tid >> 4, c_ = tid & 15;
                f32x4 s = red[s_ * 16 + c_];
#pragma unroll
                for (int q = 1; q < 16; ++q) s += red[(q * 2 + s_) * 16 + c_];
                s += *(const f32x4*)(p.b_ada + l * 6144 + v * 64 + c_ * 4);
                *(f32x4*)((float*)(ws + WS_MOD) + ((size_t)l * 2 + s_) * 6144 + v * 64 + c_ * 4) = s;
            }
            __syncthreads();
            continue;
        }
        v -= U_ADA;
        {
            bf16_t* RH = (bf16_t*)(ws + WS_ROUT) + (size_t)l * 2 * 48 * 1024; bf16_t* RL = RH + 48 * 1024;
            const int n = v;
#pragma unroll
            for (int k = tid; k < 1024; k += NTHREADS) {
                const float w = n < 4 ? p.w_rg[((size_t)l * 1024 + k) * 4 + n] : (n < 36 ? p.w_re[((size_t)l * 1024 + k) * 32 + (n - 4)] : 0.f);
                const bf16_t hi = f2bf(w); RH[n * 1024 + k] = hi; RL[n * 1024 + k] = f2bf(w - bf2f(hi));
            }
        }
    }
}

#define RC(i) (8 * lane + 512 * ((i) >> 1) + 4 * ((i) & 1))
DI u32x4 cat2(u32x2 a, u32x2 b) { return (u32x4){a.x, a.y, b.x, b.y}; }
DI u32x2 lo2(u32x4 v) { return (u32x2){v.x, v.y}; }
DI u32x2 hi2(u32x4 v) { return (u32x2){v.z, v.w}; }
DI void store_hn(bf16_t* hn, long row, int lane, const f32x4 (&x)[4], const float* modv  ) {
    float mean, rstd; row_stats(x, mean, rstd);
    u32x2 hp[4];
#pragma unroll
    for (int i = 0; i < 4; ++i) {
        const int c = RC(i);
        const f32x4 sh = *(const f32x4*)(modv + c), sc = *(const f32x4*)(modv + 1024 + c);
        hp[i] = pack4((x[i] - mean) * rstd * (sc + 1.0f) + sh);
    }
#pragma unroll
    for (int j = 0; j < 2; ++j) *(u32x4*)(hn + row * 1024 + RC(2 * j)) = cat2(hp[2 * j], hp[2 * j + 1]);
}
DI void phase_p1(const Params& p) {
    unsigned char* ws = optr(p.ws); const int tid_ = otid(), lane = tid_ & 63, wave = tid_ >> 6;
    bf16_t* X = (bf16_t*)(ws + WS_X); bf16_t* HN = (bf16_t*)(ws + WS_HN); const float* MOD = (const float*)(ws + WS_MOD);
    constexpr int RW = (T % 20 == 0) ? 5 : 4;
    for (int row0 = (blockIdx.x * 4 + wave) * RW; row0 < T; row0 += gridDim.x * 4 * RW) {
        f32x4 x[RW][4];
#pragma unroll
        for (int r = 0; r < RW; ++r) {
            const int row = row0 + r;
            const float* src = row < CTX ? p.ctx + (size_t)row * 1024 : p.x + (size_t)(row - CTX) * 1024;
#pragma unroll
            for (int i = 0; i < 4; ++i) x[r][i] = *(const f32x4*)(src + RC(i));
        }
#pragma unroll
        for (int r = 0; r < RW; ++r) {
            const int row = row0 + r;
#pragma unroll
            for (int j = 0; j < 2; ++j) *(u32x4*)(X + (size_t)row * 1024 + RC(2 * j)) = cat2(pack4h(x[r][2 * j]), pack4h(x[r][2 * j + 1]));
            store_hn(HN, row, lane, x[r], MOD + (row < CTX ? 6144 : 0));
        }
    }
}
DI void phase_i(const Params& p, int l, int dry = 0) {
    unsigned char* ws = optr(p.ws); const int tid_ = otid(), lane = tid_ & 63, wave = tid_ >> 6;
    bf16_t* X = (bf16_t*)(ws + WS_X); bf16_t* XO = dry ? (bf16_t*)(ws + WS_P + (size_t)T * 4096 + 65536) : X; bf16_t* HN = (bf16_t*)(ws + (dry ? WS_CLOC : WS_HN)); const float* MOD = (const float*)(ws + WS_MOD);
    const bf16_t* MOE = (const bf16_t*)(ws + WS_MOE);
    const bool last = (l == DEPTH - 1);
    constexpr int RW = (T % 20 == 0) ? 5 : 4;
    for (int row0 = (blockIdx.x * 4 + wave) * RW; row0 < T; row0 += gridDim.x * 4 * RW) {
        if (last && row0 + RW <= CTX) continue;
        u32x4 xq[RW][2], mq0[RW][2], mq1[RW][2];
#pragma unroll
        for (int r = 0; r < RW; ++r)
#pragma unroll
            for (int j = 0; j < 2; ++j) {
                const int c = RC(2 * j); const size_t row = (size_t)(row0 + r);
                xq[r][j] = *(const u32x4*)(X + row * 1024 + c);
                mq0[r][j] = *(const u32x4*)(MOE + (row * 2 + 0) * 1024 + c); mq1[r][j] = *(const u32x4*)(MOE + (row * 2 + 1) * 1024 + c);
            }
#pragma unroll
        for (int r = 0; r < RW; ++r) {
            const int row = row0 + r;
            if (last && row < CTX) continue;
            const float* modv = MOD + ((size_t)l * 2 + (row < CTX ? 1 : 0)) * 6144;
            f32x4 z[4];
#pragma unroll
            for (int i = 0; i < 4; ++i) {
                const int c = RC(i);
                const u32x2 xw = (i & 1) ? hi2(xq[r][i >> 1]) : lo2(xq[r][i >> 1]), a0 = (i & 1) ? hi2(mq0[r][i >> 1]) : lo2(mq0[r][i >> 1]), a1 = (i & 1) ? hi2(mq1[r][i >> 1]) : lo2(mq1[r][i >> 1]);
                const f32x4 xv = unpack4h(xw);
                const f32x4 g2 = *(const f32x4*)(modv + 5 * 1024 + c);
                f32x4 mo;
                mo[0] = bf2f((bf16_t)(a0.x & 0xffff)) + bf2f((bf16_t)(a1.x & 0xffff)); mo[1] = bf2f((bf16_t)(a0.x >> 16)) + bf2f((bf16_t)(a1.x >> 16));
                mo[2] = bf2f((bf16_t)(a0.y & 0xffff)) + bf2f((bf16_t)(a1.y & 0xffff)); mo[3] = bf2f((bf16_t)(a0.y >> 16)) + bf2f((bf16_t)(a1.y >> 16));
                z[i] = xv * ALPHA + g2 * mo;
            }
            float mean, rstd; row_stats(z, mean, rstd);
#pragma unroll
            for (int i = 0; i < 4; ++i) {
                const int c = RC(i);
                const f32x4 g = *(const f32x4*)(p.ln2_g + l * 1024 + c), b = *(const f32x4*)(p.ln2_b + l * 1024 + c);
                z[i] = (z[i] - mean) * rstd * g + b;
                if (last) *(f32x4*)(p.out + (size_t)(row - CTX) * 1024 + c) = z[i];
            }
            if (!last) {
#pragma unroll
                for (int j = 0; j < 2; ++j) *(u32x4*)(XO + (size_t)row * 1024 + RC(2 * j)) = cat2(pack4h(z[2 * j]), pack4h(z[2 * j + 1]));
            }
            if (!last) store_hn(HN, row, lane, z, MOD + ((size_t)(l + 1) * 2 + (row < CTX ? 1 : 0)) * 6144);
        }
    }
}

DI void phase_g(const Params& p, int l, unsigned char* smem, int dry = 0) {
    unsigned char* ws = optr(p.ws); const int tid_ = otid(), lane = tid_ & 63, wave = tid_ >> 6;
    bf16_t* X = (bf16_t*)(ws + WS_X); bf16_t* XO = dry ? (bf16_t*)(ws + WS_P + (size_t)T * 4096) : X; const bf16_t* ZB = (const bf16_t*)(ws + WS_ZB); bf16_t* HN = (bf16_t*)(ws + (dry ? WS_P + (size_t)T * 4096 + 65536 : WS_HN)); const float* MOD = (const float*)(ws + WS_MOD);
    const bf16_t* RH = (const bf16_t*)(ws + WS_ROUT) + (size_t)l * 2 * 48 * 1024; const bf16_t* RL = RH + 48 * 1024;
    unsigned* cnt = (unsigned*)(ws + WS_CNT) + (l * 2 + (dry ? 1 : 0)) * 2048; int* LIST = (int*)(ws + (dry ? WS_CLOC : WS_LIST)); float* LISTW = (float*)(ws + (dry ? WS_CLOC + (size_t)32 * T * 4 : WS_LISTW));
    constexpr int HST = 1032;
    bf16_t* hhi = (bf16_t*)smem; bf16_t* hlo = hhi + 16 * HST; float* lgs = (float*)(smem + 2 * 16 * HST * 2);
    const bool last = (l == DEPTH - 1);
    for (int row0 = (blockIdx.x * 4 + wave) * 4; row0 < T; row0 += gridDim.x * 16) {
        if (last && row0 < CTX) continue;
        const float* modv = MOD + ((size_t)l * 2 + (row0 < CTX ? 1 : 0)) * 6144;
        u32x4 zq[4][2];
#pragma unroll
        for (int r = 0; r < 4; ++r)
#pragma unroll
            for (int j = 0; j < 2; ++j) zq[r][j] = *(const u32x4*)(ZB + (size_t)(row0 + r) * 1024 + RC(2 * j));
#pragma unroll
        for (int r = 0; r < 4; ++r) {
            const size_t row = (size_t)(row0 + r);
            f32x4 z[4];
#pragma unroll
            for (int i = 0; i < 4; ++i) z[i] = unpack4h((i & 1) ? hi2(zq[r][i >> 1]) : lo2(zq[r][i >> 1]));
            float mean, rstd; row_stats(z, mean, rstd);
#pragma unroll
            for (int i = 0; i < 4; ++i) {
                const int c = RC(i);
                const f32x4 g = *(const f32x4*)(p.ln1_g + l * 1024 + c), b = *(const f32x4*)(p.ln1_b + l * 1024 + c);
                z[i] = (z[i] - mean) * rstd * g + b;
            }
#pragma unroll
            for (int j = 0; j < 2; ++j) *(u32x4*)(XO + row * 1024 + RC(2 * j)) = cat2(pack4h(z[2 * j]), pack4h(z[2 * j + 1]));
            row_stats(z, mean, rstd);
            u32x2 hip[4], lop[4];
#pragma unroll
            for (int i = 0; i < 4; ++i) {
                const int c = RC(i);
                const f32x4 sh = *(const f32x4*)(modv + 3 * 1024 + c), sc = *(const f32x4*)(modv + 4 * 1024 + c);
                const f32x4 hv = (z[i] - mean) * rstd * (sc + 1.0f) + sh;
                const u32x2 hi = pack4(hv);
                f32x4 d; d[0] = hv[0] - bf2f((bf16_t)(hi.x & 0xffff)); d[1] = hv[1] - bf2f((bf16_t)(hi.x >> 16)); d[2] = hv[2] - bf2f((bf16_t)(hi.y & 0xffff)); d[3] = hv[3] - bf2f((bf16_t)(hi.y >> 16));
                hip[i] = hi; lop[i] = pack4(d);
            }
#pragma unroll
            for (int j = 0; j < 2; ++j) {
                const u32x4 h16 = cat2(hip[2 * j], hip[2 * j + 1]);
                *(u32x4*)(HN + row * 1024 + RC(2 * j)) = h16;
                *(u32x4*)(hhi + (wave * 4 + r) * HST + RC(2 * j)) = h16;
                *(u32x4*)(hlo + (wave * 4 + r) * HST + RC(2 * j)) = cat2(lop[2 * j], lop[2 * j + 1]);
            }
        }
        __syncthreads();
        if (wave < 3) {
            const int fr = lane & 15, fq = lane >> 4;
            const bf16_t* rh = RH + (size_t)(wave * 16 + fr) * 1024 + 8 * fq; const bf16_t* rl = RL + (size_t)(wave * 16 + fr) * 1024 + 8 * fq;
            const bf16_t* bh = hhi + fr * HST + 8 * fq; const bf16_t* bl = hlo + fr * HST + 8 * fq;
            f32x4 a0 = (f32x4){0.f, 0.f, 0.f, 0.f}, a1 = a0, a2 = a0;
#pragma unroll 8
            for (int ks = 0; ks < 32; ++ks) {
                const bf16x8 ah = *(const bf16x8*)(rh + 32 * ks), al = *(const bf16x8*)(rl + 32 * ks);
                const bf16x8 xh = *(const bf16x8*)(bh + 32 * ks), xl = *(const bf16x8*)(bl + 32 * ks);
                a0 = MFMA16(ah, xh, a0); a1 = MFMA16(ah, xl, a1); a2 = MFMA16(al, xh, a2);
            }
            *(f32x4*)(lgs + fr * 48 + wave * 16 + 4 * fq) = a0 + (a1 + a2);
        }
        __syncthreads();
        float lg[4] = {0.f, 0.f, 0.f, 0.f};
        if (lane < 36) {
            const float bias = (lane < 4) ? p.b_rg[l * 4 + lane] : p.b_re[l * 32 + lane - 4];
#pragma unroll
            for (int r = 0; r < 4; ++r) lg[r] = lgs[(wave * 4 + r) * 48 + lane] + bias;
        }
#pragma unroll
        for (int r = 0; r < 4; ++r) {
            const float g0 = SHFL(lg[r], 0), g1 = SHFL(lg[r], 1), g2 = SHFL(lg[r], 2), g3 = SHFL(lg[r], 3);
            int grp = 0; float gm = g0;
            if (g1 > gm) { gm = g1; grp = 1; } if (g2 > gm) { gm = g2; grp = 2; } if (g3 > gm) { gm = g3; grp = 3; }
            const float pg = 1.0f / (__expf(g0 - gm) + __expf(g1 - gm) + __expf(g2 - gm) + __expf(g3 - gm));
            float e[8];
#pragma unroll
            for (int j = 0; j < 8; ++j) e[j] = SHFL(lg[r], 4 + grp * 8 + j);
            int i1 = 0; float m1 = e[0];
#pragma unroll
            for (int j = 1; j < 8; ++j) if (e[j] > m1) { m1 = e[j]; i1 = j; }
            int i2 = -1; float m2 = -3.0e38f;
#pragma unroll
            for (int j = 0; j < 8; ++j) if (j != i1 && e[j] > m2) { m2 = e[j]; i2 = j; }
            const float rr = __expf(m2 - m1), w1 = pg / (1.0f + rr), w2 = pg * rr / (1.0f + rr);
            if (lane == 0 && dry != 3) {
                const int row = row0 + r, e1 = grp * 8 + i1, e2 = grp * 8 + i2;
                const unsigned p1 = atomicAdd(&cnt[e1 * 64], 1u), p2 = atomicAdd(&cnt[e2 * 64], 1u);
                LIST[(size_t)e1 * T + p1] = row * 2 + 0; LISTW[(size_t)e1 * T + p1] = w1;
                LIST[(size_t)e2 * T + p2] = row * 2 + 1; LISTW[(size_t)e2 * T + p2] = w2;
            }
        }
    }
}

DI void phase_a(const Params& p, int l, unsigned char* smem) {
    unsigned char* ws = optr(p.ws); const int tid_ = otid(), lane = tid_ & 63, wave = tid_ >> 6, wr = wave >> 1, wc = wave & 1, fr = lane & 15, fq = lane >> 4;
    const bf16_t* HN = (const bf16_t*)(ws + WS_HN); const bf16_t* W = (const bf16_t*)(ws + WS_WIN) + (size_t)l * DINP * 1024;
    bf16_t* P = (bf16_t*)(ws + WS_P); bf16_t* PKT = (bf16_t*)(ws + WS_PKT); bf16_t* PVT = (bf16_t*)(ws + WS_PVT); float* GATES = (float*)(ws + WS_GATES);
    { int rt, ct; bool have = xcd_unit(0, RTT, 34, rt, ct), pre = false;
    for (int it = 0; have; ++it) {
        int nrt = 0, nct = 0; const bool hn = xcd_unit(it + 1, RTT, 34, nrt, nct);
        {
            f32x4 acc[MIT][4]; acc_zero(acc);
            gemm_chain(acc, RowsPlain{HN + (size_t)rt * TR * 1024, 1024}, W + (size_t)ct * 128 * 1024, 1024, 1024, smem, pre, hn, RowsPlain{HN + (size_t)nrt * TR * 1024, 1024}, W + (size_t)nct * 128 * 1024, 1024);
#pragma unroll
            for (int mi = 0; mi < MIT; ++mi) {
                const int row = rt * TR + wr * (TR / 2) + mi * 16 + fr;
                if (ct < 5) {
                    float q = 0.f;
#pragma unroll
                    for (int ni = 0; ni < 4; ++ni) { const f32x4 v = acc[mi][ni]; q += (v[0] * v[0] + v[1] * v[1]) + (v[2] * v[2] + v[3] * v[3]); }
                    q += SHFL_XOR(q, 16); q += SHFL_XOR(q, 32);
                    if (fq == 0) ((float*)(ws + WS_SSQ))[(size_t)row * 16 + ct * 2 + wc] = q;
                }
#pragma unroll
                for (int ni = 0; ni < 4; ni += 2)
                    *(u32x4*)(P + (size_t)row * DINP + ct * 128 + wc * 64 + widen_col(ni, lane)) = widen_pair(pack4(acc[mi][ni]), pack4(acc[mi][ni + 1]), lane);
#pragma unroll
                for (int ni = 0; ni < 4; ++ni) {
                    const int c0 = ct * 128 + wc * 64 + ni * 16, c = c0 + 4 * fq;
                    const f32x4 v = acc[mi][ni];
                    if (c0 >= C_PK && c0 < C_PV) {
                        *(u32x2*)(PKT + (size_t)(c - C_PK + (lane & 3)) * T + (row & ~3)) = pack4(quad_transpose(v, lane));
                    } else if (c0 >= C_PV && c0 < C_PO) {
                        *(u32x2*)(PVT + (size_t)(c - C_PV + (lane & 3)) * T + (row & ~3)) = pack4(quad_transpose(v, lane));
                    } else if (c0 == C_PG) {
                        *(f32x4*)(GATES + (size_t)row * 16 + 4 * fq) = v;
                    }
                }
            }
        }
        rt = nrt; ct = nct; have = hn; pre = hn;
    } }
}

DI void rope_angles(const float* tab, int t, int j, bool colpart, float& cs, float& sn) {
    if (t < CTX) { cs = 1.f; sn = 0.f; return; }
    const int s = t - CTX, ri = s >> 6, ci = s & 63;
    if (!colpart) { cs = tab[ri * 8 + j]; sn = tab[ROWS * 8 + ri * 8 + j]; } else { cs = tab[ROWS * 16 + ci * 8 + j]; sn = tab[ROWS * 16 + 512 + ci * 8 + j]; }
}
DI void phase_b(const Params& p, int l, unsigned char* smem) {
    unsigned char* ws = optr(p.ws); const int tid = otid(), lane = tid & 63, wave = tid >> 6, wr = wave >> 1, wc = wave & 1, fr = lane & 15, fq = lane >> 4;
    const bf16_t* P = (const bf16_t*)(ws + WS_P); const float* tab = (const float*)(ws + WS_ROPE);
    bf16_t* QB = (bf16_t*)(ws + WS_QB); bf16_t* KB = (bf16_t*)(ws + WS_KB); bf16_t* VT = (bf16_t*)(ws + WS_VT);
    constexpr int NQ = RT * 6, NKV = RTT * 8, NML = 4 * NB;
#ifndef PB_MASK
#define PB_MASK 7
#endif
    if (PB_MASK & 1)
    { int rt, ct;
    for (int it = 0; xcd_unit(it, RT, 6, rt, ct); ++it) {
        {
            f32x4 acc[4][4]; float ss[4]; acc_zero(acc);
            gemm_main<false>(acc, ss, RowsPlain{P + (size_t)rt * 128 * DINP + C_PQD, DINP}, (const bf16_t*)(ws + WS_WUQ) + (size_t)l * 768 * 384 + (size_t)ct * 128 * 384, 384, 384, smem);
#pragma unroll
            for (int mi = 0; mi < 4; ++mi) {
                const int row = rt * 128 + wr * 64 + mi * 16 + fr;
                const float* sq = (const float*)(ws + WS_SSQ) + (size_t)row * 16;
                const float rs = QSCALE / sqrtf((((sq[0] + sq[1]) + (sq[2] + sq[3])) + (sq[4] + sq[5])) * (1.0f / 384.0f) + LN_EPS);
                u32x2 qp[4];
#pragma unroll
                for (int ni = 0; ni < 4; ++ni) {
                    const int c0 = ct * 128 + wc * 64 + ni * 16, d0 = c0 % 96;
                    f32x4 v = acc[mi][ni] * rs;
                    if (d0 >= 64) {
                        f32x4 o;
#pragma unroll
                        for (int r = 0; r < 4; ++r) {
                            const float pr = SHFL_XOR(v[r], 32);
                            const int i = 4 * fq + r; float cs, sn; rope_angles(tab, row, i & 7, d0 >= 80, cs, sn);
                            o[r] = (i < 8) ? (v[r] * cs - pr * sn) : (v[r] * cs + pr * sn);
                        }
                        v = o;
                    }
                    qp[ni] = pack4(v);
                }
#pragma unroll
                for (int ni = 0; ni < 4; ni += 2) *(u32x4*)(QB + (size_t)row * 768 + ct * 128 + wc * 64 + widen_col(ni, lane)) = widen_pair(qp[ni], qp[ni + 1], lane);
            }
        }
    } }
    if (PB_MASK & 2)
    { int rt, ct;
    for (int it = 0; xcd_unit(it, RTT, 8, rt, ct); ++it) {
        {
            f32x4 acc[MIT][4]; float ss[4]; acc_zero(acc);
            gemm_main<false>(acc, ss, RowsPlain{P + (size_t)rt * TR * DINP + C_PKV, DINP}, (const bf16_t*)(ws + WS_WKV) + (size_t)l * 1024 * 256 + (size_t)ct * 128 * 256, 256, 256, smem);
#pragma unroll
            for (int mi = 0; mi < MIT; ++mi) {
                const int row = rt * TR + wr * (TR / 2) + mi * 16 + fr;
                const float* sq = (const float*)(ws + WS_SSQ) + (size_t)row * 16;
                const float rs = 1.0f / sqrtf(((sq[6] + sq[7]) + (sq[8] + sq[9])) * (1.0f / 256.0f) + LN_EPS);
                u32x2 kp[4] = {(u32x2){0u, 0u}, (u32x2){0u, 0u}, (u32x2){0u, 0u}, (u32x2){0u, 0u}};
#pragma unroll
                for (int ni = 0; ni < 4; ++ni) {
                    const int c = ct * 128 + wc * 64 + ni * 16 + 4 * fq;
                    const f32x4 v = acc[mi][ni] * rs;
                    if (c < 512) { kp[ni] = pack4(v); }
                    else {
                        *(u32x2*)(VT + (size_t)(c - 512 + (lane & 3)) * T + ((row & ~15) | ((row & 4) << 1) | ((row & 8) >> 1))) = pack4(quad_transpose(v, lane));
                    }
                }
                if (ct < 4) {
#pragma unroll
                    for (int ni = 0; ni < 4; ni += 2) *(u32x4*)(KB + (size_t)row * 768 + (ct * 2 + wc) * 96 + widen_col(ni, lane)) = widen_pair(kp[ni], kp[ni + 1], lane);
                }
            }
            if (ct == 0)
            for (int rr = tid >> 1; rr < TR; rr += NTHREADS / 2) {
                const int row = rt * TR + rr, g = tid & 1;
                const bf16_t* src = P + (size_t)row * DINP + C_KR + g * 16;
                const u32x4 a = *(const u32x4*)src, b = *(const u32x4*)(src + 8);
                float x[16];
                x[0] = bf2f(a.x & 0xffff); x[1] = bf2f(a.x >> 16); x[2] = bf2f(a.y & 0xffff); x[3] = bf2f(a.y >> 16); x[4] = bf2f(a.z & 0xffff); x[5] = bf2f(a.z >> 16); x[6] = bf2f(a.w & 0xffff); x[7] = bf2f(a.w >> 16);
                x[8] = bf2f(b.x & 0xffff); x[9] = bf2f(b.x >> 16); x[10] = bf2f(b.y & 0xffff); x[11] = bf2f(b.y >> 16); x[12] = bf2f(b.z & 0xffff); x[13] = bf2f(b.z >> 16); x[14] = bf2f(b.w & 0xffff); x[15] = bf2f(b.w >> 16);
                float o[16];
#pragma unroll
                for (int j = 0; j < 8; ++j) { float cs, sn; rope_angles(tab, row, j, g == 1, cs, sn); o[j] = x[j] * cs - x[j + 8] * sn; o[j + 8] = x[j + 8] * cs + x[j] * sn; }
                u32x4 w0, w1; w0.x = pack2(o[0], o[1]); w0.y = pack2(o[2], o[3]); w0.z = pack2(o[4], o[5]); w0.w = pack2(o[6], o[7]); w1.x = pack2(o[8], o[9]); w1.y = pack2(o[10], o[11]); w1.z = pack2(o[12], o[13]); w1.w = pack2(o[14], o[15]);
#pragma unroll
                for (int h = 0; h < 8; ++h) { bf16_t* dst = KB + (size_t)row * 768 + h * 96 + 64 + g * 16; *(u32x4*)dst = w0; *(u32x4*)(dst + 8) = w1; }
            }
        }
    } }
    if (PB_MASK & 4)
    for (int u = (blockIdx.x + gridDim.x - ((gridDim.x * 5) >> 3)) % gridDim.x; u < NML; u += gridDim.x) {
        {
            const int v0 = u, h = v0 / NB, tb = v0 % NB, dir = wave >> 1, dt = wave & 1, hh = lane >> 5, r31 = lane & 31;
            const float* GATES = (const float*)(ws + WS_GATES); const float* bg = p.b_gates + l * 16;
            const bf16_t* PKT = (const bf16_t*)(ws + WS_PKT); const bf16_t* PVT = (const bf16_t*)(ws + WS_PVT);
            float* wsb = (float*)smem + wave * 64;
            u32x4 kkr[4]; bf16x8 afr[4][4];
#pragma unroll
            for (int ks = 0; ks < 4; ++ks) kkr[ks] = *(const u32x4*)(PKT + (size_t)(h * 64 + dt * 32 + r31) * T + tb * 64 + 16 * ks + 8 * hh);
#pragma unroll
            for (int vt = 0; vt < 4; ++vt)
#pragma unroll
                for (int ks = 0; ks < 4; ++ks) afr[vt][ks] = *(const bf16x8*)(PVT + (size_t)(h * 128 + vt * 32 + r31) * T + tb * 64 + 16 * ks + 8 * hh);
            const int tau = dir ? 63 - lane : lane, t = tb * 64 + tau;
            const float ig = GATES[(size_t)t * 16 + (2 * dir) * 4 + h] + bg[(2 * dir) * 4 + h];
            const float lf = logsigmoidf_(GATES[(size_t)t * 16 + (2 * dir + 1) * 4 + h] + bg[(2 * dir + 1) * 4 + h]);
            const float b = scan_sum(lf, lane), bl = SHFL(b, 63);
            const float wlog = bl - b + ig, a = wave_max(wlog);
            wsb[tau] = __expf(wlog - a);
            const size_t sidx = ((size_t)(dir * 4 + h) * NB + tb);
            if (dt == 0 && lane == 0) { float* BLA = (float*)(ws + WS_BLA); BLA[sidx * 2 + 0] = bl; BLA[sidx * 2 + 1] = a; }
            __syncthreads();
            bf16x8 bfr[4]; float nl = 0.f;
#pragma unroll
            for (int ks = 0; ks < 4; ++ks) {
                const u32x4 kk = kkr[ks];
                const float* w8 = wsb + 16 * ks + 8 * hh;
                float f[8];
                f[0] = bf2f(kk.x & 0xffff) * w8[0]; f[1] = bf2f(kk.x >> 16) * w8[1]; f[2] = bf2f(kk.y & 0xffff) * w8[2]; f[3] = bf2f(kk.y >> 16) * w8[3];
                f[4] = bf2f(kk.z & 0xffff) * w8[4]; f[5] = bf2f(kk.z >> 16) * w8[5]; f[6] = bf2f(kk.w & 0xffff) * w8[6]; f[7] = bf2f(kk.w >> 16) * w8[7];
                nl += ((f[0] + f[1]) + (f[2] + f[3])) + ((f[4] + f[5]) + (f[6] + f[7]));
                u32x4 pk; pk.x = pack2(f[0], f[1]); pk.y = pack2(f[2], f[3]); pk.z = pack2(f[4], f[5]); pk.w = pack2(f[6], f[7]);
                bfr[ks] = __builtin_bit_cast(bf16x8, pk);
            }
            nl += SHFL_XOR(nl, 32);
            if (hh == 0) ((float*)(ws + WS_NLOC))[sidx * 64 + dt * 32 + r31] = nl;
            float* CL = (float*)(ws + WS_CLOC) + sidx * 8192;
#pragma unroll
            for (int vt = 0; vt < 4; ++vt) {
                f32x16 c;
#pragma unroll
                for (int r = 0; r < 16; ++r) c[r] = 0.f;
#pragma unroll
                for (int ks = 0; ks < 4; ++ks) {
                    c = MFMA32(afr[vt][ks], bfr[ks], c);
                }
#pragma unroll
                for (int r = 0; r < 16; ++r) CL[(vt * 32 + crow(r, hh)) * 64 + dt * 32 + r31] = c[r];
            }
            __syncthreads();
        }
    }
}

DI void attn_unit(const Params& p, int q0, int h, int nkeys, unsigned char* smem) {
    unsigned char* ws = optr(p.ws); const int tid = otid(), lane = tid & 63, wave = tid >> 6, hh = lane >> 5, r31 = lane & 31;
    const bf16_t* QB = (const bf16_t*)(ws + WS_QB); const bf16_t* KB = (const bf16_t*)(ws + WS_KB); const bf16_t* VT = (const bf16_t*)(ws + WS_VT); bf16_t* O = (bf16_t*)(ws + WS_O);
    bf16x8 qf[2][6];
#pragma unroll
    for (int qi = 0; qi < 2; ++qi)
#pragma unroll
        for (int ks = 0; ks < 6; ++ks) qf[qi][ks] = *(const bf16x8*)(QB + (size_t)(q0 + wave * 64 + qi * 32 + r31) * 768 + h * 96 + 16 * ks + 8 * hh);
    f32x16 o[2][2]; float mref[2], lsum[2]; bf16x8 biasB[2];
    const bf16x8 onesA = __builtin_bit_cast(bf16x8, (u32x4){hh == 0 ? 0x3F80u : 0u, 0u, 0u, 0u});
    const f32x16 zero16 = {0.f, 0.f, 0.f, 0.f, 0.f, 0.f, 0.f, 0.f, 0.f, 0.f, 0.f, 0.f, 0.f, 0.f, 0.f, 0.f};
#pragma unroll
    for (int qi = 0; qi < 2; ++qi) { mref[qi] = 0.f; lsum[qi] = 0.f; biasB[qi] = __builtin_bit_cast(bf16x8, (u32x4){0u, 0u, 0u, 0u});
#pragma unroll
        for (int vt = 0; vt < 2; ++vt) o[qi][vt] = zero16; }
    const bf16_t* kg = KB + h * 96; const bf16_t* vg = VT + (size_t)h * 64 * T;
    bf16_t* sb = (bf16_t*)smem;
    const int ksw = (r31 >> 2) & 3, vsw = (r31 >> 1) & 7;
    const unsigned laneK = (r31 >> 4) * 3072 + (r31 & 15) * 64 + ((hh ^ ksw) & 3) * 16, laneV = 12288 + r31 * 128 + ((hh ^ vsw) & 7) * 16;
#define ATTN_KF(B, SUB, KS) (*(const bf16x8*)((B) + ((laneK ^ (((KS) & 1) * 32)) + (SUB) * 6144 + ((KS) >> 1) * 1024)))
#define ATTN_VF(B, SUB, S2, VTI) (*(const bf16x8*)((B) + ((laneV ^ ((SUB) * 64 + (S2) * 32)) + (VTI) * 4096)))
#define ATTN_ISSUE(KT, BUF) do { unsigned char* base_ = smem + (BUF) * 20480; const unsigned l2_ = (unsigned)otid() & 63u; \
        const unsigned kofs_ = ((16u * wave + (l2_ >> 2)) * 768u + ((l2_ & 3u) ^ ((l2_ >> 4) & 3u)) * 8u) * 2u; \
        const unsigned vofs_ = ((16u * wave + (l2_ >> 3)) * (unsigned)T + ((l2_ & 7u) ^ (l2_ >> 4)) * 8u) * 2u; \
        const unsigned char* kt_ = (const unsigned char*)kg + (size_t)(KT) * (64 * 768 * 2); const unsigned char* vt_ = (const unsigned char*)vg + (size_t)(KT) * 128; \
        _Pragma("unroll") for (int g = 0; g < 3; ++g) GLDS16(kt_ + g * 64 + kofs_, base_ + (wave * 3 + g) * 1024); \
        GLDS16(vt_ + vofs_, base_ + 12288 + (wave * 2) * 1024); \
        GLDS16(vt_ + (size_t)8 * T * 2 + (vofs_ ^ 64u), base_ + 12288 + (wave * 2 + 1) * 1024); } while (0)
    ATTN_ISSUE(0, 0);
    const int nt = nkeys >> 6;
    WAIT_VM0(); __syncthreads();
    if (nt > 1) ATTN_ISSUE(1, 1);
    bool hasb;
    {
        const unsigned char* Bs = smem;
        f32x16 s[2] = {zero16, zero16};
#pragma unroll
        for (int ks = 0; ks < 6; ++ks) {
            const bf16x8 kf = ATTN_KF(Bs, 0, ks);
            s[0] = MFMA32(kf, qf[0][ks], s[0]); s[1] = MFMA32(kf, qf[1][ks], s[1]);
        }
#pragma unroll
        for (int qi = 0; qi < 2; ++qi) {
            float mx = s[qi][0];
#pragma unroll
            for (int r = 1; r < 16; ++r) mx = fmaxf(mx, s[qi][r]);
            mx = fmaxf(mx, SHFL_XOR(mx, 32));
            unsigned ub = __builtin_bit_cast(unsigned, mx); unsigned tb = ub & 0xFFFF0000u; if (mx > 0.f && (ub & 0xFFFFu)) tb += 0x10000u;
            mref[qi] = (mx > ATTN_REFHI || mx < ATTN_REFLO) ? __builtin_bit_cast(float, tb) : 0.f;
            const unsigned nb = (__builtin_bit_cast(unsigned, -mref[qi])) >> 16;
            biasB[qi] = __builtin_bit_cast(bf16x8, (u32x4){hh == 0 ? nb : 0u, 0u, 0u, 0u});
        }
        hasb = WAVE_ANY(mref[0] != 0.f || mref[1] != 0.f);
    }
    int kt = 0;
    while (kt < nt && !hasb) {
        const unsigned char* Bs = smem + (kt & 1) * 20480;
        float rsm = 0.f;
#pragma unroll
        for (int sub = 0; sub < 2; ++sub) {
            f32x16 s0 = zero16, s1 = zero16;
#pragma unroll
            for (int ks = 0; ks < 6; ++ks) {
                const bf16x8 kf = ATTN_KF(Bs, sub, ks);
                s0 = MFMA32(kf, qf[0][ks], s0); s1 = MFMA32(kf, qf[1][ks], s1);
            }
            float rs0 = 0.f; bf16x8 pf0[2];
            {
#pragma unroll
                for (int r = 0; r < 16; ++r) { const float e = EXP2F(s0[r]); s0[r] = e; rs0 += e; NOSLP(rs0); }
#pragma unroll
                for (int s2 = 0; s2 < 2; ++s2) { u32x4 pk; pk.x = pack2(s0[8 * s2 + 0], s0[8 * s2 + 1]); pk.y = pack2(s0[8 * s2 + 2], s0[8 * s2 + 3]); pk.z = pack2(s0[8 * s2 + 4], s0[8 * s2 + 5]); pk.w = pack2(s0[8 * s2 + 6], s0[8 * s2 + 7]); pf0[s2] = __builtin_bit_cast(bf16x8, pk); }
            }
#pragma unroll
            for (int vt = 0; vt < 2; ++vt)
#pragma unroll
                for (int s2 = 0; s2 < 2; ++s2) {
                    o[0][vt] = MFMA32(ATTN_VF(Bs, sub, s2, vt), pf0[s2], o[0][vt]);
                }
            float rs1 = 0.f; bf16x8 pf1[2];
            {
#pragma unroll
                for (int r = 0; r < 16; ++r) { const float e = EXP2F(s1[r]); s1[r] = e; rs1 += e; NOSLP(rs1); }
#pragma unroll
                for (int s2 = 0; s2 < 2; ++s2) { u32x4 pk; pk.x = pack2(s1[8 * s2 + 0], s1[8 * s2 + 1]); pk.y = pack2(s1[8 * s2 + 2], s1[8 * s2 + 3]); pk.z = pack2(s1[8 * s2 + 4], s1[8 * s2 + 5]); pk.w = pack2(s1[8 * s2 + 6], s1[8 * s2 + 7]); pf1[s2] = __builtin_bit_cast(bf16x8, pk); }
            }
#pragma unroll
            for (int vt = 0; vt < 2; ++vt)
#pragma unroll
                for (int s2 = 0; s2 < 2; ++s2) {
                    o[1][vt] = MFMA32(ATTN_VF(Bs, sub, s2, vt), pf1[s2], o[1][vt]);
                }
            lsum[0] += rs0; lsum[1] += rs1; rsm = fmaxf(rsm, fmaxf(rs0, rs1));
        }
        if (WAVE_ANY(!(rsm < ATTN_BIG))) {
            hasb = true;
            const float rm = fmaxf(rsm, SHFL_XOR(rsm, 32));
            if (rm >= ATTN_BIG) {
                const float d = (float)((int)((__builtin_bit_cast(unsigned, rm) >> 23) & 0xFF) - 126);
#pragma unroll
                for (int qi = 0; qi < 2; ++qi) {
                    const float mt = mref[qi] + d;
                    unsigned ub = __builtin_bit_cast(unsigned, mt); unsigned tb = ub & 0xFFFF0000u; if (mt > 0.f && (ub & 0xFFFFu)) tb += 0x10000u;
                    const float mn = __builtin_bit_cast(float, tb), al = EXP2F(mref[qi] - mn);
                    lsum[qi] *= al;
#pragma unroll
                    for (int vt = 0; vt < 2; ++vt) o[qi][vt] *= al;
                    mref[qi] = mn;
                    const unsigned nb = (__builtin_bit_cast(unsigned, -mn)) >> 16;
                    biasB[qi] = __builtin_bit_cast(bf16x8, (u32x4){hh == 0 ? nb : 0u, 0u, 0u, 0u});
                }
            }
        }
        ++kt;
        if (kt < nt) { WAIT_VM0(); __syncthreads(); if (kt + 1 < nt) ATTN_ISSUE(kt + 1, (kt + 1) & 1); }
    }
    while (kt < nt) {
        const unsigned char* Bs = smem + (kt & 1) * 20480;
        float rsm = 0.f;
#pragma unroll
        for (int sub = 0; sub < 2; ++sub) {
            f32x16 s0 = MFMA32(onesA, biasB[0], zero16), s1 = MFMA32(onesA, biasB[1], zero16);
#pragma unroll
            for (int ks = 0; ks < 6; ++ks) {
                const bf16x8 kf = ATTN_KF(Bs, sub, ks);
                s0 = MFMA32(kf, qf[0][ks], s0); s1 = MFMA32(kf, qf[1][ks], s1);
            }
            float rs0 = 0.f; bf16x8 pf0[2];
            {
#pragma unroll
                for (int r = 0; r < 16; ++r) { const float e = EXP2F(s0[r]); s0[r] = e; rs0 += e; NOSLP(rs0); }
#pragma unroll
                for (int s2 = 0; s2 < 2; ++s2) { u32x4 pk; pk.x = pack2(s0[8 * s2 + 0], s0[8 * s2 + 1]); pk.y = pack2(s0[8 * s2 + 2], s0[8 * s2 + 3]); pk.z = pack2(s0[8 * s2 + 4], s0[8 * s2 + 5]); pk.w = pack2(s0[8 * s2 + 6], s0[8 * s2 + 7]); pf0[s2] = __builtin_bit_cast(bf16x8, pk); }
            }
#pragma unroll
            for (int vt = 0; vt < 2; ++vt)
#pragma unroll
                for (int s2 = 0; s2 < 2; ++s2) {
                    o[0][vt] = MFMA32(ATTN_VF(Bs, sub, s2, vt), pf0[s2], o[0][vt]);
                }
            float rs1 = 0.f; bf16x8 pf1[2];
            {
#pragma unroll
                for (int r = 0; r < 16; ++r) { const float e = EXP2F(s1[r]); s1[r] = e; rs1 += e; NOSLP(rs1); }
#pragma unroll
                for (int s2 = 0; s2 < 2; ++s2) { u32x4 pk; pk.x = pack2(s1[8 * s2 + 0], s1[8 * s2 + 1]); pk.y = pack2(s1[8 * s2 + 2], s1[8 * s2 + 3]); pk.z = pack2(s1[8 * s2 + 4], s1[8 * s2 + 5]); pk.w = pack2(s1[8 * s2 + 6], s1[8 * s2 + 7]); pf1[s2] = __builtin_bit_cast(bf16x8, pk); }
            }
#pragma unroll
            for (int vt = 0; vt < 2; ++vt)
#pragma unroll
                for (int s2 = 0; s2 < 2; ++s2) {
                    o[1][vt] = MFMA32(ATTN_VF(Bs, sub, s2, vt), pf1[s2], o[1][vt]);
                }
            lsum[0] += rs0; lsum[1] += rs1; rsm = fmaxf(rsm, fmaxf(rs0, rs1));
        }
        if (WAVE_ANY(!(rsm < ATTN_BIG))) {
            hasb = true;
            const float rm = fmaxf(rsm, SHFL_XOR(rsm, 32));
            if (rm >= ATTN_BIG) {
                const float d = (float)((int)((__builtin_bit_cast(unsigned, rm) >> 23) & 0xFF) - 126);
#pragma unroll
                for (int qi = 0; qi < 2; ++qi) {
                    const float mt = mref[qi] + d;
                    unsigned ub = __builtin_bit_cast(unsigned, mt); unsigned tb = ub & 0xFFFF0000u; if (mt > 0.f && (ub & 0xFFFFu)) tb += 0x10000u;
                    const float mn = __builtin_bit_cast(float, tb), al = EXP2F(mref[qi] - mn);
                    lsum[qi] *= al;
#pragma unroll
                    for (int vt = 0; vt < 2; ++vt) o[qi][vt] *= al;
                    mref[qi] = mn;
                    const unsigned nb = (__builtin_bit_cast(unsigned, -mn)) >> 16;
                    biasB[qi] = __builtin_bit_cast(bf16x8, (u32x4){hh == 0 ? nb : 0u, 0u, 0u, 0u});
                }
            }
        }
        ++kt;
        if (kt < nt) { WAIT_VM0(); __syncthreads(); if (kt + 1 < nt) ATTN_ISSUE(kt + 1, (kt + 1) & 1); }
    }
    __syncthreads();
#undef ATTN_ISSUE
#undef ATTN_KF
#undef ATTN_VF
#pragma unroll
    for (int qi = 0; qi < 2; ++qi) {
        const float lt = lsum[qi] + SHFL_XOR(lsum[qi], 32), inv = 1.0f / lt;
        const size_t row = (size_t)(q0 + wave * 64 + qi * 32 + r31);
#pragma unroll
        for (int vt = 0; vt < 2; ++vt)
#pragma unroll
            for (int g = 0; g < 4; ++g) {
                f32x4 v; v[0] = o[qi][vt][4 * g] * inv; v[1] = o[qi][vt][4 * g + 1] * inv; v[2] = o[qi][vt][4 * g + 2] * inv; v[3] = o[qi][vt][4 * g + 3] * inv;
                *(u32x2*)(O + row * 512 + h * 64 + vt * 32 + 8 * g + 4 * hh) = pack4(v);
            }
    }
}
DI int chain_tb(int dir, int c) { return dir == 0 ? c : (c < NCB ? NCB - 1 - c : NB - 1 - (c - NCB)); }
DI void scan_unit(const Params& p, int su, unsigned char* smem) {
    constexpr int SB = (NB % 13 == 0) ? 13 : 4;
    static_assert(NB % SB == 0, "scan batch");
    unsigned char* ws = optr(p.ws); const int tid = otid();
    const bool isn = su >= 64;
    const int dh = isn ? su - 64 : su >> 3, part = su & 7, dir = dh >> 2;
    float* sbla = (float*)smem; int* stb = (int*)(smem + 8 * NB);
    { const float* BLA = (const float*)(ws + WS_BLA);
      for (int i = tid; i < NB; i += NTHREADS) { const int tb = chain_tb(dir, i); stb[i] = tb; sbla[2 * i] = BLA[((size_t)dh * NB + tb) * 2]; sbla[2 * i + 1] = BLA[((size_t)dh * NB + tb) * 2 + 1]; } }
    __syncthreads();
    if (!isn || tid < 16) {
        const int stride = isn ? 64 : 8192;
        const float* SRC = isn ? (const float*)(ws + WS_NLOC) + (size_t)dh * NB * 64 + tid * 4 : (const float*)(ws + WS_CLOC) + (size_t)dh * NB * 8192 + (part * 256 + tid) * 4;
        bf16_t* CP = (bf16_t*)(ws + WS_CPREV) + (size_t)dh * NB * 8192 + (part * 256 + tid) * 4;
        float* NP = (float*)(ws + WS_NPREV) + (size_t)dh * NB * 64 + tid * 4;
        float* MPREV = (float*)(ws + WS_MPREV) + (size_t)dh * NB;
        f32x4 st = (f32x4){0.f, 0.f, 0.f, 0.f}; float m = 0.f;
        for (int c0 = 0; c0 < NB; c0 += SB) {
            f32x4 cl[SB];
#pragma unroll
            for (int j = 0; j < SB; ++j) cl[j] = *(const f32x4*)(SRC + (size_t)stb[c0 + j] * stride);
#pragma unroll
            for (int j = 0; j < SB; ++j) {
                const int tb = stb[c0 + j];
                if (isn) *(f32x4*)(NP + (size_t)tb * 64) = st; else *(u32x2*)(CP + (size_t)tb * 8192) = pack4(st);
                if (!isn && part == 0 && tid == 0) MPREV[tb] = m;
                const float bl = sbla[2 * (c0 + j)], a = sbla[2 * (c0 + j) + 1];
                const float mn = fmaxf(bl + m, a), fc = __expf(bl + m - mn), fl = __expf(a - mn);
                st = st * fc + cl[j] * fl; m = mn;
            }
        }
    }
    __syncthreads();
}
DI void phase_c(const Params& p, unsigned char* smem) {
    constexpr int NLQ = SEQ / 256, NCQ = CTX / 256, NATT = NLQ * 8, NSC = 72;
    for (int u = blockIdx.x; u < NLQ * 8; u += gridDim.x) attn_unit(p, CTX + (u >> 3) * 256, u & 7, T, smem);
    for (int u = (blockIdx.x + gridDim.x - (NATT % gridDim.x)) % gridDim.x; u < NSC; u += gridDim.x) scan_unit(p, u, smem);
}

constexpr int NCV = 32 * 192, NCV_D = 2880, NCV_E = 4512;
DI void convert_experts(const Params& p, int l, int lo, int hi, unsigned char* smem, bool dtail);
DI void phase_d(const Params& p, int l, unsigned char* smem) {
    unsigned char* ws = optr(p.ws); const int tid = otid(), lane = tid & 63, wave = tid >> 6, hh = lane >> 5, r31 = lane & 31, dir = wave >> 1, jt = wave & 1;
    const bf16_t* P = (const bf16_t*)(ws + WS_P); const bf16_t* PVT = (const bf16_t*)(ws + WS_PVT); const float* GATES = (const float*)(ws + WS_GATES); const float* bg = p.b_gates + l * 16;
    bf16_t* HM = (bf16_t*)(ws + WS_HM);
    float* gsm = (float*)smem + wave * 192;
    float* hx = (float*)(smem + 4096);
    for (int u = blockIdx.x; u < 4 * NB; u += gridDim.x) {
        const int h = u / NB, tb = u % NB, t0 = tb * 64;
        const size_t sidx = ((size_t)(dir * 4 + h) * NB + tb);
        const float mprev = ((const float*)(ws + WS_MPREV))[sidx];
        const int tj = jt * 32 + r31;
        const bf16_t* CP = (const bf16_t*)(ws + WS_CPREV) + sidx * 8192;
        bf16x8 qf[4], cfr[4][4], kfr[2][4];
#pragma unroll
        for (int ks = 0; ks < 4; ++ks) qf[ks] = *(const bf16x8*)(P + (size_t)(t0 + tj) * DINP + C_PQ + h * 64 + 16 * ks + 8 * hh);
#pragma unroll
        for (int vt = 0; vt < 4; ++vt)
#pragma unroll
            for (int ks = 0; ks < 4; ++ks) cfr[vt][ks] = *(const bf16x8*)(CP + (vt * 32 + r31) * 64 + 16 * ks + 8 * hh);
#pragma unroll
        for (int st = 0; st < 2; ++st)
#pragma unroll
            for (int ks = 0; ks < 4; ++ks) kfr[st][ks] = *(const bf16x8*)(P + (size_t)(t0 + st * 32 + r31) * DINP + C_PK + h * 64 + 16 * ks + 8 * hh);
        {
            const int tau = dir ? 63 - lane : lane, t = t0 + tau;
            const float ig = GATES[(size_t)t * 16 + (2 * dir) * 4 + h] + bg[(2 * dir) * 4 + h];
            const float lf = logsigmoidf_(GATES[(size_t)t * 16 + (2 * dir + 1) * 4 + h] + bg[(2 * dir + 1) * 4 + h]);
            const float b = scan_sum(lf, lane), uu = ig - b, pm = fmaxf(mprev, scan_max(uu, lane));
            gsm[tau] = uu; gsm[64 + tau] = b; gsm[128 + tau] = pm;
        }
        __syncthreads();
        const float pmj = gsm[128 + tj], bj = gsm[64 + tj], mj = bj + pmj, scj = __expf(mprev - pmj);
        f32x16 acc[4];
#pragma unroll
        for (int vt = 0; vt < 4; ++vt) {
#pragma unroll
            for (int r = 0; r < 16; ++r) acc[vt][r] = 0.f;
#pragma unroll
            for (int ks = 0; ks < 4; ++ks) acc[vt] = MFMA32(cfr[vt][ks], qf[ks], acc[vt]);
            acc[vt] *= (scj * 0.125f);
        }
        float qn = 0.f;
        {
            const float* NP = (const float*)(ws + WS_NPREV) + sidx * 64;
#pragma unroll
            for (int ks = 0; ks < 4; ++ks)
#pragma unroll
                for (int j = 0; j < 8; ++j) qn += bf2f((bf16_t)qf[ks][j]) * NP[16 * ks + 8 * hh + j];
            qn += SHFL_XOR(qn, 32);
        }
        float rowsum = 0.f;
#pragma unroll
        for (int st = 0; st < 2; ++st) {
            f32x16 s;
#pragma unroll
            for (int r = 0; r < 16; ++r) s[r] = 0.f;
#pragma unroll
            for (int ks = 0; ks < 4; ++ks) s = MFMA32(kfr[st][ks], qf[ks], s);
#pragma unroll
            for (int r = 0; r < 16; ++r) {
                const int ts = st * 32 + crow(r, hh);
                const bool ok = dir ? (ts >= tj) : (ts <= tj);
                const float w = ok ? __expf(gsm[ts] - pmj) : 0.f;
                s[r] = s[r] * 0.125f * w; rowsum += s[r];
            }
#pragma unroll
            for (int s2 = 0; s2 < 2; ++s2) {
                u32x4 pk; pk.x = pack2(s[8 * s2 + 0], s[8 * s2 + 1]); pk.y = pack2(s[8 * s2 + 2], s[8 * s2 + 3]); pk.z = pack2(s[8 * s2 + 4], s[8 * s2 + 5]); pk.w = pack2(s[8 * s2 + 6], s[8 * s2 + 7]);
                const bf16x8 pf = __builtin_bit_cast(bf16x8, pk);
#pragma unroll
                for (int vt = 0; vt < 4; ++vt) {
                    const bf16_t* va = PVT + (size_t)(h * 128 + vt * 32 + r31) * T + t0 + st * 32 + 16 * s2 + 4 * hh;
                    const u32x2 lo = *(const u32x2*)va, hi = *(const u32x2*)(va + 8);
                    u32x4 vv; vv.x = lo.x; vv.y = lo.y; vv.z = hi.x; vv.w = hi.y;
                    acc[vt] = MFMA32(__builtin_bit_cast(bf16x8, vv), pf, acc[vt]);
                }
            }
        }
        rowsum += SHFL_XOR(rowsum, 32);
        const float nq = rowsum + scj * 0.125f * qn;
        const float inv = 1.0f / fmaxf(fabsf(nq), __expf(-mj));
        if (dir == 1) {
#pragma unroll
            for (int vt = 0; vt < 4; ++vt)
#pragma unroll
                for (int r = 0; r < 16; ++r) hx[tj * 132 + vt * 32 + crow(r, hh)] = acc[vt][r] * inv;
        }
        __syncthreads();
        if (dir == 0) {
            float s1 = 0.f;
#pragma unroll
            for (int vt = 0; vt < 4; ++vt)
#pragma unroll
                for (int r = 0; r < 16; ++r) { const float v = acc[vt][r] * inv + hx[tj * 132 + vt * 32 + crow(r, hh)]; acc[vt][r] = v; s1 += v; }
            s1 += SHFL_XOR(s1, 32);
            const float mean = s1 * (1.0f / 128.0f);
            float s2 = 0.f;
#pragma unroll
            for (int vt = 0; vt < 4; ++vt)
#pragma unroll
                for (int r = 0; r < 16; ++r) { const float dlt = acc[vt][r] - mean; s2 += dlt * dlt; }
            s2 += SHFL_XOR(s2, 32);
            const float rstd = 1.0f / sqrtf(s2 * (1.0f / 128.0f) + LN_EPS);
#pragma unroll
            for (int vt = 0; vt < 4; ++vt)
#pragma unroll
                for (int r = 0; r < 16; ++r) hx[tj * 132 + vt * 32 + crow(r, hh)] = (acc[vt][r] - mean) * rstd;
        }
        __syncthreads();
        {
            const int tk = tid >> 2, qv = tid & 3; const size_t t = (size_t)(t0 + tk);
            const float* src = hx + tk * 132 + qv * 32; const bf16_t* po = P + t * DINP + C_PO + h * 128 + qv * 32; const float* gm = p.g_mh + l * 512 + h * 128 + qv * 32;
            bf16_t* dst = HM + t * 512 + h * 128 + qv * 32;
#pragma unroll
            for (int c = 0; c < 32; c += 8) {
                const u32x4 pw = *(const u32x4*)(po + c);
                float o8[8];
                const unsigned pws[4] = {pw.x, pw.y, pw.z, pw.w};
#pragma unroll
                for (int j = 0; j < 4; ++j) {
                    o8[2 * j] = src[c + 2 * j] * gm[c + 2 * j] * sigmoidf_(bf2f((bf16_t)(pws[j] & 0xffff)));
                    o8[2 * j + 1] = src[c + 2 * j + 1] * gm[c + 2 * j + 1] * sigmoidf_(bf2f((bf16_t)(pws[j] >> 16)));
                }
                u32x4 w; w.x = pack2(o8[0], o8[1]); w.y = pack2(o8[2], o8[3]); w.z = pack2(o8[4], o8[5]); w.w = pack2(o8[6], o8[7]);
                *(u32x4*)(dst + c) = w;
            }
        }
        __syncthreads();
    }
    {
        constexpr int NCQ8 = (CTX / 256) * 8;
        for (int u = (int)gridDim.x - 1 - (int)blockIdx.x; u < NCQ8; u += gridDim.x) attn_unit(p, (u >> 3) * 256, u & 7, CTX, smem);
    }
    convert_experts(p, l, 0, NCV_D, smem, true);
}

DI void convert_experts(const Params& p, int l, int lo, int hi, unsigned char* smem, bool dtail) {
    unsigned char* ws = optr(p.ws);
    const int G = gridDim.x;
    int idx = blockIdx.x, cnt = G;
    if (dtail) {
        const int left = (4 * NB) % G, top = (CTX / 256) * 8;
        if (left && left + top < G) { if ((int)blockIdx.x < left || (int)blockIdx.x >= G - top) return; idx = blockIdx.x - left; cnt = G - left - top; }
    } else if (!(G & 7)) {
        const int nx = G >> 3, Lx = ((RTT & ~7) >> 3) * 8, rem = Lx % nx, left = (RTT - (RTT & ~7)) * 8, j = blockIdx.x >> 3, x = blockIdx.x & 7;
        if (rem) { if (j < rem) return; idx = (j - rem) * 8 + x; cnt = (nx - rem) * 8; }
        else if (left && left < G) { if ((int)blockIdx.x < left) return; idx = blockIdx.x - left; cnt = G - left; }
    }
    for (int u = lo + idx; u < hi; u += cnt) {
        const int e = u / 192, w = u % 192;
        if (w < 64) transpose_tile(p.w_e_gate + ((size_t)l * 32 + e) * 1024 * 256, 256, 256, (w / 4) * 64, (w % 4) * 64, (bf16_t*)(ws + WS_WGU) + (size_t)e * 512 * 1024, 1024, 0, nullptr, MapGU{0}, smem);
        else if (w < 128) transpose_tile(p.w_e_up + ((size_t)l * 32 + e) * 1024 * 256, 256, 256, ((w - 64) / 4) * 64, ((w - 64) % 4) * 64, (bf16_t*)(ws + WS_WGU) + (size_t)e * 512 * 1024, 1024, 0, nullptr, MapGU{1}, smem);
        else transpose_tile(p.w_e_down + ((size_t)l * 32 + e) * 256 * 1024, 1024, 1024, ((w - 128) / 16) * 64, ((w - 128) % 16) * 64, (bf16_t*)(ws + WS_WD) + (size_t)e * 1024 * 256, 256, 0, nullptr, MapId(), smem);
    }
}

DI void phase_e(const Params& p, int l, unsigned char* smem) {
    unsigned char* ws = optr(p.ws); const int tid_ = otid(), lane = tid_ & 63, wave = tid_ >> 6, wr = wave >> 1, wc = wave & 1, fr = lane & 15, fq = lane >> 4;
    const bf16_t* P = (const bf16_t*)(ws + WS_P); const bf16_t* W = (const bf16_t*)(ws + WS_WBO) + (size_t)l * 1024 * 1024; bf16_t* U = (bf16_t*)(ws + WS_U);
    int rt, ct;
    for (int it = 0; xcd_unit(it, RTT, 8, rt, ct); ++it) {
        f32x4 acc[MIT][4]; u32x2 t1[MIT][4]; float ss[4]; acc_zero(acc);
        gemm_main<false>(acc, ss, RowsPlain{(const bf16_t*)(ws + WS_O) + (size_t)rt * TR * 512, 512}, W + (size_t)ct * 128 * 1024, 1024, 512, smem);
#pragma unroll
        for (int mi = 0; mi < MIT; ++mi)
#pragma unroll
            for (int ni = 0; ni < 4; ++ni) {
                const size_t row = (size_t)rt * TR + wr * (TR / 2) + mi * 16 + fr; const int c = ct * 128 + wc * 64 + ni * 16 + 4 * fq;
                const u32x2 g = *(const u32x2*)(P + row * DINP + C_PM + c);
                f32x4 s; s[0] = sigmoidf_(bf2f((bf16_t)(g.x & 0xffff))); s[1] = sigmoidf_(bf2f((bf16_t)(g.x >> 16))); s[2] = sigmoidf_(bf2f((bf16_t)(g.y & 0xffff))); s[3] = sigmoidf_(bf2f((bf16_t)(g.y >> 16)));
                t1[mi][ni] = pack4(acc[mi][ni] * s);
            }
        acc_zero(acc);
        gemm_main<false>(acc, ss, RowsPlain{(const bf16_t*)(ws + WS_HM) + (size_t)rt * TR * 512, 512}, W + (size_t)ct * 128 * 1024 + 512, 1024, 512, smem);
#pragma unroll
        for (int mi = 0; mi < MIT; ++mi)
#pragma unroll
            for (int ni = 0; ni < 4; ++ni) {
                const size_t row = (size_t)rt * TR + wr * (TR / 2) + mi * 16 + fr; const int c = ct * 128 + wc * 64 + ni * 16 + 4 * fq;
                const u32x2 g = *(const u32x2*)(P + row * DINP + C_PM + 1024 + c);
                f32x4 s; s[0] = sigmoidf_(bf2f((bf16_t)(g.x & 0xffff))); s[1] = sigmoidf_(bf2f((bf16_t)(g.x >> 16))); s[2] = sigmoidf_(bf2f((bf16_t)(g.y & 0xffff))); s[3] = sigmoidf_(bf2f((bf16_t)(g.y >> 16)));
                f32x4 tv; tv[0] = bf2f((bf16_t)(t1[mi][ni].x & 0xffff)); tv[1] = bf2f((bf16_t)(t1[mi][ni].x >> 16)); tv[2] = bf2f((bf16_t)(t1[mi][ni].y & 0xffff)); tv[3] = bf2f((bf16_t)(t1[mi][ni].y >> 16));
                t1[mi][ni] = pack4(tv + acc[mi][ni] * s);
            }
#pragma unroll
        for (int mi = 0; mi < MIT; ++mi)
#pragma unroll
            for (int ni = 0; ni < 4; ni += 2)
                *(u32x4*)(U + ((size_t)rt * TR + wr * (TR / 2) + mi * 16 + fr) * 1024 + ct * 128 + wc * 64 + widen_col(ni, lane)) = widen_pair(t1[mi][ni], t1[mi][ni + 1], lane);
    }
    convert_experts(p, l, NCV_D, NCV_E, smem, false);
}

DI void phase_f(const Params& p, int l, unsigned char* smem, int dry = 0) {
    unsigned char* ws = optr(p.ws); const int tid_ = otid(), lane = tid_ & 63, wave = tid_ >> 6, wr = wave >> 1, wc = wave & 1, fr = lane & 15, fq = lane >> 4;
    const bf16_t* W = (const bf16_t*)(ws + WS_WOUT) + (size_t)l * 1024 * 1024; const bf16_t* X = (const bf16_t*)(ws + WS_X); const float* MOD = (const float*)(ws + WS_MOD);
    const bool last = (l == DEPTH - 1);
    int rt, ct; bool have = xcd_unit(0, RTT, 8, rt, ct), pre = false;
    for (int it = 0; have; ++it) {
        int nrt = 0, nct = 0; const bool hn = xcd_unit(it + 1, RTT, 8, nrt, nct);
        const bool skip = last && (rt + 1) * TR <= CTX, nskip = last && (nrt + 1) * TR <= CTX, chain = hn && !nskip;
        if (skip) { rt = nrt; ct = nct; have = hn; pre = false; continue; }
        f32x4 acc[MIT][4]; acc_zero(acc);
        gemm_chain(acc, RowsPlain{(const bf16_t*)(ws + WS_U) + (size_t)rt * TR * 1024, 1024}, W + (size_t)ct * 128 * 1024, 1024, 1024, smem, pre, chain, RowsPlain{(const bf16_t*)(ws + WS_U) + (size_t)nrt * TR * 1024, 1024}, W + (size_t)nct * 128 * 1024, 1024);
#pragma unroll
        for (int mi = 0; mi < MIT; ++mi)
            {
                const size_t row = (size_t)rt * TR + wr * (TR / 2) + mi * 16 + fr;
                const float* g1 = MOD + ((size_t)l * 2 + (row < (size_t)CTX ? 1 : 0)) * 6144 + 2 * 1024;
                u32x2 zp[4];
#pragma unroll
                for (int ni = 0; ni < 4; ++ni) {
                    const int c = ct * 128 + wc * 64 + ni * 16 + 4 * fq;
                    const f32x4 xv = unpack4h(*(const u32x2*)(X + row * 1024 + c)), g = *(const f32x4*)(g1 + c);
                    zp[ni] = pack4h(xv * ALPHA + g * acc[mi][ni]);
                }
                bf16_t* zo = (bf16_t*)(ws + WS_ZB + (dry ? (size_t)T * 2048 : 0)) + row * 1024 + ct * 128 + wc * 64;
#pragma unroll
                for (int ni = 0; ni < 4; ni += 2) *(u32x4*)(zo + widen_col(ni, lane)) = widen_pair(zp[ni], zp[ni + 1], lane);
            }
        rt = nrt; ct = nct; have = hn; pre = chain;
    }
    if (!dry) convert_experts(p, l, NCV_E, NCV, smem, false);
}

DI void moe_offsets(const unsigned* cnt, int* s_nt, int* s_off, int* s_pre, int per_tile_units) {
    if (threadIdx.x == 0) {
        int off = 0, pre = 0;
        for (int e = 0; e < 32; ++e) { const int n = (int)cnt[e * 64], nt = (n + TH - 1) / TH; s_nt[e] = nt; s_off[e] = off; s_pre[e] = pre; off += nt * TH; pre += nt * per_tile_units; }
        s_pre[32] = pre;
    }
    __syncthreads();
}
DI void phase_h1(const Params& p, int l, unsigned char* smem) {
    unsigned char* ws = optr(p.ws); const int tid_ = otid(), lane = tid_ & 63, wave = tid_ >> 6, wr = wave >> 1, wc = wave & 1, fr = lane & 15, fq = lane >> 4;
    const unsigned* cnt = (const unsigned*)(ws + WS_CNT) + l * 4096; const int* LIST = (const int*)(ws + WS_LIST); const float* LISTW = (const float*)(ws + WS_LISTW);
    int* s_nt = (int*)(smem + LDS_BYTES); int* s_off = s_nt + 32; int* s_pre = s_off + 32;
    moe_offsets(cnt, s_nt, s_off, s_pre, 4);
    const int total = s_pre[32];
    for (int u = blockIdx.x; u < total; u += gridDim.x) {
        int e = 0; while (u >= s_pre[e + 1]) ++e;
        const int v = u - s_pre[e], rt = v >> 2, ct = v & 3, n = (int)cnt[e * 64] - rt * TH;
        f32x4 acc[MIH][4]; float ss[4]; acc_zero(acc);
        gemm_main<false>(acc, ss, RowsGather{(const bf16_t*)(ws + WS_HN), LIST + (size_t)e * T + rt * TH, n}, (const bf16_t*)(ws + WS_WGU) + ((size_t)e * 512 + ct * 128) * 1024, 1024, 1024, smem);
        bf16_t* HID = (bf16_t*)(ws + WS_HID) + (size_t)(s_off[e] + rt * TH) * 256;
#pragma unroll
        for (int mi = 0; mi < MIH; ++mi) {
            const int r = wr * (TH / 2) + mi * 16 + fr;
            const float w = (r < n) ? LISTW[(size_t)e * T + rt * TH + r] : 0.f;
            u32x2 hp[2];
#pragma unroll
            for (int ni = 0; ni < 4; ni += 2) {
                const f32x4 a = acc[mi][ni], b = acc[mi][ni + 1]; f32x4 hd;
#pragma unroll
                for (int j = 0; j < 4; ++j) hd[j] = siluf_(a[j]) * b[j] * w;
                hp[ni >> 1] = pack4(hd);
            }
            const u32x4 hw = widen_pair(hp[0], hp[1], lane);
            if (r < n) *(u32x4*)(HID + (size_t)r * 256 + ct * 64 + wc * 32 + widen_col(0, lane)) = hw;
        }
    }
}
DI void phase_h2(const Params& p, int l, unsigned char* smem) {
    unsigned char* ws = optr(p.ws); const int tid_ = otid(), lane = tid_ & 63, wave = tid_ >> 6, wr = wave >> 1, wc = wave & 1, fr = lane & 15, fq = lane >> 4;
    const unsigned* cnt = (const unsigned*)(ws + WS_CNT) + l * 4096; const int* LIST = (const int*)(ws + WS_LIST);
    int* s_nt = (int*)(smem + LDS_BYTES); int* s_off = s_nt + 32; int* s_pre = s_off + 32;
    moe_offsets(cnt, s_nt, s_off, s_pre, 8);
    const int total = s_pre[32];
    bf16_t* MOE = (bf16_t*)(ws + WS_MOE);
    for (int u = blockIdx.x; u < total; u += gridDim.x) {
        int e = 0; while (u >= s_pre[e + 1]) ++e;
        const int v = u - s_pre[e], rt = v >> 3, ct = v & 7, n = (int)cnt[e * 64] - rt * TH;
        f32x4 acc[MIH][4]; float ss[4]; acc_zero(acc);
        gemm_main<false>(acc, ss, RowsPlain{(const bf16_t*)(ws + WS_HID) + (size_t)(s_off[e] + rt * TH) * 256, 256}, (const bf16_t*)(ws + WS_WD) + ((size_t)e * 1024 + ct * 128) * 256, 256, 256, smem);
#pragma unroll
        for (int mi = 0; mi < MIH; ++mi) {
            const int r = wr * (TH / 2) + mi * 16 + fr;
            const u32x4 w0 = widen_pair(pack4(acc[mi][0]), pack4(acc[mi][1]), lane), w1 = widen_pair(pack4(acc[mi][2]), pack4(acc[mi][3]), lane);
            if (r < n) {
                const int ent = LIST[(size_t)e * T + rt * TH + r];
                bf16_t* dst = MOE + (size_t)ent * 1024 + ct * 128 + wc * 64;
                *(u32x4*)(dst + widen_col(0, lane)) = w0; *(u32x4*)(dst + widen_col(2, lane)) = w1;
            }
        }
    }
}

#ifndef EMU
#define GRID_SYNC() xcd_barrier(bar)
#else
#define GRID_SYNC() emu::grid_sync()
#endif
#ifndef PHASE_MASK
#define PHASE_MASK 0xFFF
#endif
#define PH_IN(ph) ((ph) >= p.ph_lo && (ph) < p.ph_hi)
#define PH_ON(k) ((PHASE_MASK >> (k)) & 1)

#define PH_SEAM(ph) do { if (PH_IN(ph) && (ph) + 1 < p.ph_hi) { GRID_SYNC(); if (PROBE_DUP == 20) GRID_SYNC(); } } while (0)

__global__ void __launch_bounds__(NTHREADS, 2) mega_fwd(Params p) {
    SMEM_DECL
#ifndef EMU
    if (threadIdx.x == 0) *(uint4*)(smem + LDS_BYTES + 512) = make_uint4(0u, 0u, 0u, 0u);
    __syncthreads();
    XcdBarrier bar = xcd_barrier_post((unsigned*)(p.ws + WS_BAR), (volatile LAS unsigned*)(smem + LDS_BYTES + 512));
#endif
    if (PH_ON(10) && PH_IN(0)) { phase_p0(p, smem); if (PROBE_DUP == 10) { __syncthreads(); phase_p0(p, smem); } }
    PH_SEAM(0);
    if (PH_ON(11) && PH_IN(1)) phase_p1(p);
    PH_SEAM(1);
    for (int l = 0; l < DEPTH; ++l) {
        const int b = 2 + l * NPH;
        if (b + NPH <= p.ph_lo || b >= p.ph_hi) continue;
        if (PH_ON(0) && PH_IN(b + 0)) { phase_a(p, l, smem); if (PROBE_DUP == 0) { __syncthreads(); phase_a(p, l, smem); } }
        PH_SEAM(b + 0);
        if (PH_ON(1) && PH_IN(b + 1)) { phase_b(p, l, smem); if (PROBE_DUP == 1) { __syncthreads(); phase_b(p, l, smem); } }
        PH_SEAM(b + 1);
        if (PH_ON(2) && PH_IN(b + 2)) { phase_c(p, smem); if (PROBE_DUP == 2) { __syncthreads(); phase_c(p, smem); } }
        PH_SEAM(b + 2);
        if (PH_ON(3) && PH_IN(b + 3)) { phase_d(p, l, smem); if (PROBE_DUP == 3) { __syncthreads(); phase_d(p, l, smem); } }
        PH_SEAM(b + 3);
        if (PH_ON(4) && PH_IN(b + 4)) { phase_e(p, l, smem); if (PROBE_DUP == 4) { __syncthreads(); phase_e(p, l, smem); } }
        PH_SEAM(b + 4);
        if (PH_ON(5) && PH_IN(b + 5)) { if (PROBE_DUP == 5) { phase_f(p, l, smem, 1); __syncthreads(); } phase_f(p, l, smem); }
        PH_SEAM(b + 5);
        if (PH_ON(6) && PH_IN(b + 6)) { if (PROBE_DUP == 6) { phase_g(p, l, smem, 1); __syncthreads(); } if (PROBE_DUP == 62) { phase_g(p, l, smem, 2); __syncthreads(); } if (PROBE_DUP == 63) { phase_g(p, l, smem, 3); __syncthreads(); } phase_g(p, l, smem); }
        PH_SEAM(b + 6);
        if (PH_ON(7) && PH_IN(b + 7)) { phase_h1(p, l, smem); if (PROBE_DUP == 7) { __syncthreads(); phase_h1(p, l, smem); } }
        PH_SEAM(b + 7);
        if (PH_ON(8) && PH_IN(b + 8)) { phase_h2(p, l, smem); if (PROBE_DUP == 8) { __syncthreads(); phase_h2(p, l, smem); } }
        PH_SEAM(b + 8);
        if (PH_ON(9) && PH_IN(b + 9)) { if (PROBE_DUP == 9) { phase_i(p, l, 1); __syncthreads(); } phase_i(p, l); }
        PH_SEAM(b + 9);
    }
}

extern "C" void kernel_launch(void* const* d_in, const int* in_sizes, int n_in, void* d_out, int out_size, void* d_ws, size_t ws_size, hipStream_t stream) {
    Params p;
    memset(&p, 0, sizeof(p));
    const float** f = (const float**)&p;
    for (int i = 0; i < 28; ++i) f[i] = (const float*)d_in[i];
    p.out = (float*)d_out; p.ws = (unsigned char*)d_ws;
    constexpr int LDS_TOTAL = LDS_BYTES + 1024;
#ifndef EMU
    static int grid = 0;
    if (grid == 0) {
        if (n_in != 28 || ws_size < WS_END) { fprintf(stderr, "kernel_launch: need 28 inputs and %zu bytes of workspace (got %d, %zu)\n", (size_t)WS_END, n_in, ws_size); grid = -1; return; }
        int dev = 0, cus = 0, per_cu = 0;
        hipGetDevice(&dev); hipDeviceGetAttribute(&cus, hipDeviceAttributeMultiprocessorCount, dev);
        if (hipFuncSetAttribute((const void*)mega_fwd, hipFuncAttributeMaxDynamicSharedMemorySize, LDS_TOTAL) != hipSuccess) { fprintf(stderr, "kernel_launch: hipFuncSetAttribute failed\n"); grid = -1; return; }
        if (hipOccupancyMaxActiveBlocksPerMultiprocessor(&per_cu, (const void*)mega_fwd, NTHREADS, LDS_TOTAL) != hipSuccess || per_cu < 1) per_cu = 1;
        (void)hipGetLastError();
        grid = cus * (per_cu < 2 ? per_cu : 2);
    }
    if (grid < 0) return;
    hipMemsetAsync((char*)d_ws + WS_BAR, 0, WS_ZERO_BYTES, stream);
#if N_LAUNCH_MODE == 0
    p.ph_lo = 0; p.ph_hi = NPHASE_TOTAL;
    hipLaunchKernelGGL(mega_fwd, dim3(grid), dim3(NTHREADS), LDS_TOTAL, stream, p);
#else
    for (int ph = 0; ph < NPHASE_TOTAL; ++ph) { p.ph_lo = ph; p.ph_hi = ph + 1; hipLaunchKernelGGL(mega_fwd, dim3(grid), dim3(NTHREADS), LDS_TOTAL, stream, p); }
#endif
#else
    if (ws_size < WS_END) { fprintf(stderr, "EMU: workspace too small: need %zu\n", (size_t)WS_END); exit(1); }
    if (emu_ph_lo == 0) memset((char*)d_ws + WS_BAR, 0, WS_ZERO_BYTES);
    if (emu_one_launch) { p.ph_lo = emu_ph_lo; p.ph_hi = emu_ph_hi; emu::launch([p]() { mega_fwd(p); }, emu_grid, NTHREADS, LDS_TOTAL, true); }
    else for (int ph = emu_ph_lo; ph < emu_ph_hi; ++ph) { p.ph_lo = ph; p.ph_hi = ph + 1; fprintf(stderr, "EMU phase %d\n", ph); emu::launch([p]() { mega_fwd(p); }, emu_grid, NTHREADS, LDS_TOTAL, false); }
#endif
}
```

```cpp
#ifndef EMU
#include <hip/hip_runtime.h>
#include <cstdio>
#include <cstdint>
#include <cstring>
#endif

#ifndef SEQ
#define SEQ 16384
#endif
#ifndef CTX
#define CTX 256
#endif
#ifndef DEPTH
#define DEPTH 4
#endif
#ifndef PROBE_DUP
#define PROBE_DUP -1
#endif
#ifndef ATTN_BIG
#define ATTN_BIG 1099511627776.f
#endif
#ifndef ATTN_REFHI
#define ATTN_REFHI 40.f
#endif
#define ATTN_REFLO -100.f
#ifndef N_LAUNCH_MODE
#define N_LAUNCH_MODE 0
#endif

#define DI __device__ __forceinline__
typedef unsigned short bf16_t;
typedef short bf16x8 __attribute__((ext_vector_type(8)));
typedef short bf16x4 __attribute__((ext_vector_type(4)));
typedef float f32x4 __attribute__((ext_vector_type(4)));
typedef float f32x16 __attribute__((ext_vector_type(16)));
typedef unsigned u32x4 __attribute__((ext_vector_type(4)));
typedef unsigned u32x2 __attribute__((ext_vector_type(2)));

#ifndef EMU
#define SMEM_DECL extern __shared__ __attribute__((aligned(16))) unsigned char smem[];
#define MFMA16(a, b, c) __builtin_amdgcn_mfma_f32_16x16x32_bf16((a), (b), (c), 0, 0, 0)
#define MFMA32(a, b, c) __builtin_amdgcn_mfma_f32_32x32x16_bf16((a), (b), (c), 0, 0, 0)
#define SHFL(v, s) __shfl((v), (s))
#define SHFL_XOR(v, m) __shfl_xor((v), (m))
#define SHFL_UP(v, d) __shfl_up((v), (d))
#define EXP2F(x) __builtin_amdgcn_exp2f(x)
#define RCPF(x) __builtin_amdgcn_rcpf(x)
#define WAVE_SYNC() __builtin_amdgcn_wave_barrier()
#define WAVE_ANY(p) (__any((int)(p)) != 0)
#define GLDS16(gptr, ldsptr) __builtin_amdgcn_global_load_lds((const unsigned*)(gptr), (unsigned __attribute__((address_space(3)))*)(ldsptr), 16, 0, 0)
#define WAIT_VM0() asm volatile("s_waitcnt vmcnt(0)" ::: "memory")
#define NOSLP(x) asm("" : "+v"(x))
#else
#define SMEM_DECL unsigned char* smem = emu::lds();
#define MFMA16(a, b, c) emu_mfma16((a), (b), (c))
#define MFMA32(a, b, c) emu_mfma32((a), (b), (c))
#define SHFL(v, s) emu_shfl((v), (s))
#define SHFL_XOR(v, m) emu_shfl_xor((v), (m))
#define SHFL_UP(v, d) emu_shfl_up((v), (d))
#define EXP2F(x) exp2f(x)
#define RCPF(x) (1.0f / (x))
#define WAVE_SYNC() emu::wave_sync(emu::wav())
#define WAVE_ANY(p) emu_any((int)(p))
#define GLDS16(gptr, ldsptr) memcpy((unsigned char*)(ldsptr) + 16 * (threadIdx.x & 63), (gptr), 16)
#define WAIT_VM0() do {} while (0)
#define NOSLP(x) do {} while (0)
#define __expf(x) expf(x)
#endif

constexpr int D = 1024, T = CTX + SEQ, NB = T / 64, NCB = CTX / 64, RT = T / 128, ROWS = SEQ / 64;
constexpr int DIN = 4272, DINP = 4352;
constexpr int C_PQD = 0, C_PKV = 384, C_KR = 640, C_PQ = 672, C_PK = 928, C_PV = 1184, C_PO = 1696, C_PG = 2208, C_PM = 2224;
constexpr float LN_EPS = 1e-6f;
constexpr float ALPHA = 1.6817928305074290f;
constexpr float QSCALE = 0.10206207261596575f * 1.4426950408889634f;
constexpr int NPH = 10;
constexpr int NPHASE_TOTAL = 2 + DEPTH * NPH;
constexpr int LDS_BYTES = 73728;
constexpr int TH = 160, MIH = TH / 32;
constexpr int TR = (T % 160 == 0) ? 160 : 128, MIT = TR / 32, RTT = T / TR;
constexpr int NTHREADS = 256;

constexpr size_t al256(size_t x) { return (x + 255) & ~(size_t)255; }
constexpr size_t WS_BAR = 0;
constexpr size_t WS_CNT = 16384;
constexpr size_t WS_ZERO_BYTES = 16384 + 65536;
constexpr size_t WS_MOD = WS_ZERO_BYTES;
constexpr size_t WS_ROPE = al256(WS_MOD + (size_t)DEPTH * 2 * 6144 * 4);
constexpr size_t WS_ROUT = al256(WS_ROPE + ((size_t)ROWS * 16 + 1024) * 4);
constexpr size_t WS_WIN = al256(WS_ROUT + (size_t)DEPTH * 2 * 48 * 1024 * 2);
constexpr size_t WS_WUQ = al256(WS_WIN + (size_t)DEPTH * DINP * 1024 * 2);
constexpr size_t WS_WKV = al256(WS_WUQ + (size_t)DEPTH * 768 * 384 * 2);
constexpr size_t WS_WBO = al256(WS_WKV + (size_t)DEPTH * 1024 * 256 * 2);
constexpr size_t WS_WOUT = al256(WS_WBO + (size_t)DEPTH * 1024 * 1024 * 2);
constexpr size_t WS_WGU = al256(WS_WOUT + (size_t)DEPTH * 1024 * 1024 * 2);
constexpr size_t WS_WD = al256(WS_WGU + (size_t)32 * 512 * 1024 * 2);
constexpr size_t WS_X = al256(WS_WD + (size_t)32 * 1024 * 256 * 2);
constexpr size_t WS_HN = al256(WS_X + (size_t)T * 1024 * 4);
constexpr size_t WS_P = al256(WS_HN + (size_t)T * 1024 * 2);
constexpr size_t WS_ZB = WS_P;
constexpr size_t WS_MOE = WS_P;
constexpr size_t WS_HID = al256(WS_P + (size_t)T * DINP * 2);
constexpr size_t WS_GATES = al256(WS_HID + (size_t)(2 * T + 32 * TH) * 256 * 2);
constexpr size_t WS_SSQ = al256(WS_GATES + (size_t)T * 16 * 4);
constexpr size_t WS_QB = al256(WS_SSQ + (size_t)T * 16 * 4);
constexpr size_t WS_KB = al256(WS_QB + (size_t)T * 768 * 2);
constexpr size_t WS_U = WS_QB;
constexpr size_t WS_VT = al256(WS_KB + (size_t)T * 768 * 2);
constexpr size_t WS_PKT = al256(WS_VT + (size_t)512 * T * 2);
constexpr size_t WS_PVT = al256(WS_PKT + (size_t)256 * T * 2);
constexpr size_t WS_O = al256(WS_PVT + (size_t)512 * T * 2);
constexpr size_t WS_HM = al256(WS_O + (size_t)T * 512 * 2);
constexpr size_t WS_CLOC = al256(WS_HM + (size_t)T * 512 * 2);
constexpr size_t WS_NLOC = al256(WS_CLOC + (size_t)8 * NB * 8192 * 4);
constexpr size_t WS_BLA = al256(WS_NLOC + (size_t)8 * NB * 64 * 4);
constexpr size_t WS_CPREV = al256(WS_BLA + (size_t)8 * NB * 2 * 4);
constexpr size_t WS_NPREV = al256(WS_CPREV + (size_t)8 * NB * 8192 * 2);
constexpr size_t WS_MPREV = al256(WS_NPREV + (size_t)8 * NB * 64 * 4);
constexpr size_t WS_LIST = al256(WS_MPREV + (size_t)8 * NB * 4);
constexpr size_t WS_LISTW = al256(WS_LIST + (size_t)32 * T * 4);
constexpr size_t WS_END = al256(WS_LISTW + (size_t)32 * T * 4);

struct Params {
    const float *x, *c, *ctx, *c_ctx, *w_ada, *b_ada, *w_in, *b_gates, *w_uq, *w_uk, *w_uv, *g_qn, *g_kvn, *g_mh, *w_bo_mla, *w_bo_mlstm, *w_out, *ln1_g, *ln1_b,
        *w_rg, *b_rg, *w_re, *b_re, *w_e_gate, *w_e_up, *w_e_down, *ln2_g, *ln2_b;
    float* out; unsigned char* ws;
    int ph_lo, ph_hi;
};

#ifndef EMU
DI int otid() { int t = threadIdx.x; asm volatile("" : "+v"(t)); return t; }
DI unsigned char* optr(unsigned char* q) { asm volatile("" : "+s"(q)); return q; }
DI int oint(int v) { asm volatile("" : "+s"(v)); return v; }
#else
DI int otid() { return threadIdx.x; }
DI unsigned char* optr(unsigned char* q) { return q; }
DI int oint(int v) { return v; }
#endif
DI float bf2f(bf16_t h) { return __builtin_bit_cast(float, (unsigned)h << 16); }
DI bf16_t f2bf(float f) { unsigned u = __builtin_bit_cast(unsigned, f); u += 0x7fffu + ((u >> 16) & 1u); return (bf16_t)(u >> 16); }
#ifndef EMU
typedef __bf16 bf16x2_hw __attribute__((ext_vector_type(2)));
typedef float f32x2_hw __attribute__((ext_vector_type(2)));
#endif
DI unsigned pack2(float lo, float hi) {
#ifndef EMU
    const f32x2_hw v = {lo, hi}; return __builtin_bit_cast(unsigned, __builtin_convertvector(v, bf16x2_hw));
#else
    return (unsigned)f2bf(lo) | ((unsigned)f2bf(hi) << 16);
#endif
}
DI u32x2 pack4(f32x4 v) { u32x2 r; r.x = pack2(v[0], v[1]); r.y = pack2(v[2], v[3]); return r; }
DI unsigned pack2h(float lo, float hi) { return (unsigned)__builtin_bit_cast(unsigned short, (_Float16)lo) | ((unsigned)__builtin_bit_cast(unsigned short, (_Float16)hi) << 16); }
DI u32x2 pack4h(f32x4 v) { u32x2 r; r.x = pack2h(v[0], v[1]); r.y = pack2h(v[2], v[3]); return r; }
DI float h2f(unsigned short h) { return (float)__builtin_bit_cast(_Float16, h); }
DI f32x4 unpack4h(u32x2 w) { f32x4 r; r[0] = h2f((unsigned short)(w.x & 0xffff)); r[1] = h2f((unsigned short)(w.x >> 16)); r[2] = h2f((unsigned short)(w.y & 0xffff)); r[3] = h2f((unsigned short)(w.y >> 16)); return r; }
DI f32x4 quad_transpose(f32x4 v, int lane) {
    const bool b1 = lane & 2, b0 = lane & 1;
    { const float a0 = b1 ? v[0] : v[2], a1 = b1 ? v[1] : v[3]; const float r0 = SHFL_XOR(a0, 2), r1 = SHFL_XOR(a1, 2); if (b1) { v[0] = r0; v[1] = r1; } else { v[2] = r0; v[3] = r1; } }
    { const float a0 = b0 ? v[0] : v[1], a1 = b0 ? v[2] : v[3]; const float r0 = SHFL_XOR(a0, 1), r1 = SHFL_XOR(a1, 1); if (b0) { v[0] = r0; v[2] = r1; } else { v[1] = r0; v[3] = r1; } }
    return v;
}
DI u32x4 widen_pair(u32x2 a, u32x2 b, int lane) {
#ifndef EMU
    const u32x2 r0 = __builtin_amdgcn_permlane16_swap(a.x, b.x, false, false), r1 = __builtin_amdgcn_permlane16_swap(a.y, b.y, false, false);
    return (u32x4){r0[0], r1[0], r0[1], r1[1]};
#else
    const bool odd = (lane >> 4) & 1;
    const unsigned sx = odd ? a.x : b.x, sy = odd ? a.y : b.y, rx = SHFL_XOR(sx, 16), ry = SHFL_XOR(sy, 16);
    if (odd) { a.x = rx; a.y = ry; } else { b.x = rx; b.y = ry; }
    return (u32x4){a.x, a.y, b.x, b.y};
#endif
}
DI u32x2 lo2(u32x4 v) { return (u32x2){v.x, v.y}; }
DI u32x2 hi2(u32x4 v) { return (u32x2){v.z, v.w}; }
DI int widen_col(int ni, int lane) { const int fq = lane >> 4; return (fq & 1) ? (ni + 1) * 16 + 4 * (fq - 1) : ni * 16 + 4 * fq; }
DI float wave_sum(float v) { v += SHFL_XOR(v, 32); v += SHFL_XOR(v, 16); v += SHFL_XOR(v, 8); v += SHFL_XOR(v, 4); v += SHFL_XOR(v, 2); v += SHFL_XOR(v, 1); return v; }
DI float wave_max(float v) { v = fmaxf(v, SHFL_XOR(v, 32)); v = fmaxf(v, SHFL_XOR(v, 16)); v = fmaxf(v, SHFL_XOR(v, 8)); v = fmaxf(v, SHFL_XOR(v, 4)); v = fmaxf(v, SHFL_XOR(v, 2)); v = fmaxf(v, SHFL_XOR(v, 1)); return v; }
DI float scan_sum(float v, int lane) {
#pragma unroll
    for (int d = 1; d < 64; d <<= 1) { float t = SHFL_UP(v, d); if (lane >= d) v += t; } return v; }
DI float scan_max(float v, int lane) {
#pragma unroll
    for (int d = 1; d < 64; d <<= 1) { float t = SHFL_UP(v, d); if (lane >= d) v = fmaxf(v, t); } return v; }
DI float sigmoidf_(float x) { return RCPF(1.0f + EXP2F(-1.4426950408889634f * x)); }
DI float siluf_(float x) { return x * RCPF(1.0f + EXP2F(-1.4426950408889634f * x)); }
DI float logsigmoidf_(float x) { return fminf(x, 0.f) - log1pf(__expf(-fabsf(x))); }
DI int crow(int r, int hh) { return (r & 3) + 8 * (r >> 2) + 4 * hh; }

#ifndef EMU
#define XB_TMO      128
#define XB_XCNT(j)  (256  + 64 * (j))
#define XB_XSUB(j)  (1280 + 64 * (j))
#define XB_XGEN(j)  (2304 + 64 * (j))
#define XB_TOP      3328
#define XB_TOPGEN   3392
#define XCD_BAR_WORDS 3456
#define XB_SPIN_CAP (1u << 22)
#define LAS __attribute__((address_space(3)))
__device__ __forceinline__ unsigned xb_ld(unsigned* p)              { return __hip_atomic_load(p, __ATOMIC_RELAXED, __HIP_MEMORY_SCOPE_AGENT); }
__device__ __forceinline__ unsigned xb_add(unsigned* p, unsigned v) { return __hip_atomic_fetch_add(p, v, __ATOMIC_RELAXED, __HIP_MEMORY_SCOPE_AGENT); }
__device__ __forceinline__ unsigned xb_xcc_id() { return (unsigned)__builtin_amdgcn_s_getreg((3 << 11) | 20) & 0xFu; }
#define XB_SPIN(cond, bar) do { unsigned _sp = 0; while (cond) { __builtin_amdgcn_s_sleep(1); \
    if ((++_sp & 255u) == 0u) { if (xb_ld(&(bar)[XB_TMO])) break; if (_sp > XB_SPIN_CAP) { atomicAdd(&(bar)[XB_TMO], 1u); break; } } } } while (0)
struct XcdBarrier { unsigned* bar; unsigned x; volatile LAS unsigned* st; };
__device__ __forceinline__ XcdBarrier xcd_barrier_post(unsigned* bar, volatile LAS unsigned* st) {
    XcdBarrier b; b.bar = bar; b.x = xb_xcc_id(); b.st = st;
    if (threadIdx.x == 0) (void)xb_add(&bar[XB_XCNT(b.x)], 1u);
    return b;
}
__device__ __forceinline__ void xcd_barrier_complete(unsigned* bar, unsigned x, unsigned& nloc, unsigned& nx) {
    const unsigned G = gridDim.x * gridDim.y * gridDim.z;
    unsigned sum, cnt, mine, sp = 0u;
    for (;;) {
        sum = 0u; cnt = 0u; mine = 0u;
#pragma unroll
        for (unsigned j = 0; j < 16; ++j) { const unsigned c = xb_ld(&bar[XB_XCNT(j)]); sum += c; cnt += (c > 0u) ? 1u : 0u; mine = (j == x) ? c : mine; }
        if (sum == G) break;
        __builtin_amdgcn_s_sleep(1);
        if ((++sp & 255u) == 0u) { if (xb_ld(&bar[XB_TMO])) break; if (sp > XB_SPIN_CAP) { atomicAdd(&bar[XB_TMO], 1u); break; } }
    }
    nloc = mine > 0u ? mine : 1u; nx = cnt > 0u ? cnt : 1u;
}
__device__ __forceinline__ void xcd_barrier(const XcdBarrier& b) {
    asm volatile("s_waitcnt vmcnt(0)" ::: "memory");
    __syncthreads();
    if (threadIdx.x == 0) {
        unsigned* bar = b.bar;
        __builtin_amdgcn_s_waitcnt(0);
        unsigned nloc = b.st[0], nx = b.st[1];
        if (nloc == 0u) { xcd_barrier_complete(bar, b.x, nloc, nx); b.st[0] = nloc; b.st[1] = nx; }
        const unsigned old = xb_add(&bar[XB_XSUB(b.x)], 1u);
        const unsigned gen = old / nloc;
        if (old + 1u == (gen + 1u) * nloc) {
            __builtin_amdgcn_fence(__ATOMIC_RELEASE, "agent");
            asm volatile("s_waitcnt vmcnt(0)" ::: "memory");
            const unsigned og = xb_add(&bar[XB_TOP], 1u);
            const unsigned tg = og / nx;
            if (og + 1u == (tg + 1u) * nx) xb_add(&bar[XB_TOPGEN], 1u);
            else XB_SPIN(xb_ld(&bar[XB_TOPGEN]) == tg, bar);
            __builtin_amdgcn_fence(__ATOMIC_ACQUIRE, "agent");
            xb_add(&bar[XB_XGEN(b.x)], 1u);
            asm volatile("s_waitcnt vmcnt(0)" ::: "memory");
        } else {
            XB_SPIN(xb_ld(&bar[XB_XGEN(b.x)]) == gen, bar);
            __builtin_amdgcn_fence(__ATOMIC_ACQUIRE, "agent");
            asm volatile("s_waitcnt vmcnt(0)" ::: "memory");
        }
    }
    __syncthreads();
}
#endif

struct RowsPlain { const bf16_t* base; long ld; DI const bf16_t* row(int r) const { return base + (long)r * ld; } };
struct RowsGather { const bf16_t* base; const int* list; int n; DI const bf16_t* row(int r) const { const int tok = (r < n) ? (list[r] >> 1) : 0; return base + (long)tok * 1024; } };

DI float sumsq8(u32x4 v) {
    float a0 = bf2f((bf16_t)(v.x & 0xffff)), a1 = bf2f((bf16_t)(v.x >> 16)), a2 = bf2f((bf16_t)(v.y & 0xffff)), a3 = bf2f((bf16_t)(v.y >> 16));
    float a4 = bf2f((bf16_t)(v.z & 0xffff)), a5 = bf2f((bf16_t)(v.z >> 16)), a6 = bf2f((bf16_t)(v.w & 0xffff)), a7 = bf2f((bf16_t)(v.w >> 16));
    return ((a0 * a0 + a1 * a1) + (a2 * a2 + a3 * a3)) + ((a4 * a4 + a5 * a5) + (a6 * a6 + a7 * a7));
}
template <bool STATS, class AR, int MI>
DI void gemm_main(f32x4 (&acc)[MI][4], float (&ss)[4], const AR& ar, const bf16_t* __restrict__ Bt, long ldb, int K, unsigned char* smem) {
    constexpr int ABYTES = 4096 * MI, STAGE = ABYTES + 16384;
    const int tid = otid(), lane = tid & 63, wave = tid >> 6, wr = wave >> 1, wc = wave & 1;
    const bf16_t* ap[MI]; const bf16_t* bp[4];
#pragma unroll
    for (int i = 0; i < MI; ++i) { const int pos = (wave * MI + i) * 64 + lane, row = pos >> 3, c = (pos & 7) ^ ((row >> 1) & 7); ap[i] = ar.row(row) + c * 8; }
#pragma unroll
    for (int i = 0; i < 4; ++i) { const int pos = (wave * 4 + i) * 64 + lane, row = pos >> 3, c = (pos & 7) ^ ((row >> 1) & 7); bp[i] = Bt + (long)row * ldb + c * 8; }
#define GEMM_ISSUE(KT, BUF) do { unsigned char* base_ = smem + (BUF) * STAGE; \
        _Pragma("unroll") for (int i = 0; i < MI; ++i) GLDS16(ap[i] + (KT) * 64, base_ + (wave * MI + i) * 1024); \
        _Pragma("unroll") for (int i = 0; i < 4; ++i) GLDS16(bp[i] + (KT) * 64, base_ + ABYTES + (wave * 4 + i) * 1024); } while (0)
    GEMM_ISSUE(0, 0);
    const int nk = K >> 6;
    const int fr = lane & 15, fq = lane >> 4, sw = (fr >> 1) & 7;
    for (int kt = 0; kt < nk; ++kt) {
        WAIT_VM0(); __syncthreads();
        if (kt + 1 < nk) GEMM_ISSUE(kt + 1, (kt + 1) & 1);
        const bf16_t* As = (const bf16_t*)(smem + (kt & 1) * STAGE); const bf16_t* Bs = As + ABYTES / 2;
#pragma unroll
        for (int ks = 0; ks < 2; ++ks) {
            bf16x8 a[MI], b[4];
#pragma unroll
            for (int i = 0; i < MI; ++i) a[i] = *(const bf16x8*)(As + (wr * 16 * MI + i * 16 + fr) * 64 + ((ks * 4 + fq) ^ sw) * 8);
#pragma unroll
            for (int i = 0; i < 4; ++i) b[i] = *(const bf16x8*)(Bs + (wc * 64 + i * 16 + fr) * 64 + ((ks * 4 + fq) ^ sw) * 8);
#pragma unroll
            for (int mi = 0; mi < MI; ++mi)
#pragma unroll
                for (int ni = 0; ni < 4; ++ni) acc[mi][ni] = MFMA16(b[ni], a[mi], acc[mi][ni]);
        }
    }
    __syncthreads();
#undef GEMM_ISSUE
}
template <class AR, int MI>
DI void gemm_chain(f32x4 (&acc)[MI][4], const AR& ar, const bf16_t* __restrict__ Bt, long ldb, int K, unsigned char* smem,
                   bool pre, bool has_next, const AR& nar, const bf16_t* __restrict__ nBt, long nldb) {
    constexpr int ABYTES = 4096 * MI, STAGE = ABYTES + 16384;
    const int tid = otid(), lane = tid & 63, wave = tid >> 6, wr = wave >> 1, wc = wave & 1;
    const bf16_t* ap[MI]; const bf16_t* bp[4];
#pragma unroll
    for (int i = 0; i < MI; ++i) { const int pos = (wave * MI + i) * 64 + lane, row = pos >> 3, c = (pos & 7) ^ ((row >> 1) & 7); ap[i] = ar.row(row) + c * 8; }
#pragma unroll
    for (int i = 0; i < 4; ++i) { const int pos = (wave * 4 + i) * 64 + lane, row = pos >> 3, c = (pos & 7) ^ ((row >> 1) & 7); bp[i] = Bt + (long)row * ldb + c * 8; }
#define GEMM_ISSUE(KT, BUF) do { unsigned char* base_ = smem + (BUF) * STAGE; \
        _Pragma("unroll") for (int i = 0; i < MI; ++i) GLDS16(ap[i] + (KT) * 64, base_ + (wave * MI + i) * 1024); \
        _Pragma("unroll") for (int i = 0; i < 4; ++i) GLDS16(bp[i] + (KT) * 64, base_ + ABYTES + (wave * 4 + i) * 1024); } while (0)
    if (!pre) GEMM_ISSUE(0, 0);
    const int nk = K >> 6;
    const int fr = lane & 15, fq = lane >> 4, sw = (fr >> 1) & 7;
    for (int kt = 0; kt < nk; ++kt) {
        WAIT_VM0(); __syncthreads();
        if (kt + 1 < nk) GEMM_ISSUE(kt + 1, (kt + 1) & 1);
        else if (has_next) {
#pragma unroll
            for (int i = 0; i < MI; ++i) { const int pos = (wave * MI + i) * 64 + lane, row = pos >> 3, c = (pos & 7) ^ ((row >> 1) & 7); ap[i] = nar.row(row) + c * 8; }
#pragma unroll
            for (int i = 0; i < 4; ++i) { const int pos = (wave * 4 + i) * 64 + lane, row = pos >> 3, c = (pos & 7) ^ ((row >> 1) & 7); bp[i] = nBt + (long)row * nldb + c * 8; }
            GEMM_ISSUE(0, 0);
        }
        const bf16_t* As = (const bf16_t*)(smem + (kt & 1) * STAGE); const bf16_t* Bs = As + ABYTES / 2;
#pragma unroll
        for (int ks = 0; ks < 2; ++ks) {
            bf16x8 a[MI], b[4];
#pragma unroll
            for (int i = 0; i < MI; ++i) a[i] = *(const bf16x8*)(As + (wr * 16 * MI + i * 16 + fr) * 64 + ((ks * 4 + fq) ^ sw) * 8);
#pragma unroll
            for (int i = 0; i < 4; ++i) b[i] = *(const bf16x8*)(Bs + (wc * 64 + i * 16 + fr) * 64 + ((ks * 4 + fq) ^ sw) * 8);
#pragma unroll
            for (int mi = 0; mi < MI; ++mi)
#pragma unroll
                for (int ni = 0; ni < 4; ++ni) acc[mi][ni] = MFMA16(b[ni], a[mi], acc[mi][ni]);
        }
    }
    __syncthreads();
#undef GEMM_ISSUE
}
template <int MI>
DI void acc_zero(f32x4 (&acc)[MI][4]) {
#pragma unroll
    for (int i = 0; i < MI; ++i)
#pragma unroll
        for (int j = 0; j < 4; ++j) acc[i][j] = (f32x4){0.f, 0.f, 0.f, 0.f};
}

template <class MAP>
DI void transpose_tile(const float* __restrict__ src, int ld_src, int C, int r0, int c0, bf16_t* __restrict__ dst, int ld_dst, int dst_col0, const float* g, const MAP& map, unsigned char* smem) {
    float* s = (float*)smem;
    const int tid = otid();
#pragma unroll
    for (int i = 0; i < 4; ++i) {
        const int id = tid + 256 * i, r = id >> 4, c4 = (id & 15) * 4;
        f32x4 v = (f32x4){0.f, 0.f, 0.f, 0.f};
        if (c0 + c4 < C) v = *(const f32x4*)(src + (long)(r0 + r) * ld_src + c0 + c4);
        const float gs = g ? g[r0 + r] : 1.0f;
        s[r * 65 + c4 + 0] = v[0] * gs; s[r * 65 + c4 + 1] = v[1] * gs; s[r * 65 + c4 + 2] = v[2] * gs; s[r * 65 + c4 + 3] = v[3] * gs;
    }
    __syncthreads();
#pragma unroll
    for (int i = 0; i < 2; ++i) {
        const int id = tid + 256 * i, c = id >> 3, r8 = (id & 7) * 8;
        u32x4 w;
        w.x = pack2(s[(r8 + 0) * 65 + c], s[(r8 + 1) * 65 + c]); w.y = pack2(s[(r8 + 2) * 65 + c], s[(r8 + 3) * 65 + c]);
        w.z = pack2(s[(r8 + 4) * 65 + c], s[(r8 + 5) * 65 + c]); w.w = pack2(s[(r8 + 6) * 65 + c], s[(r8 + 7) * 65 + c]);
        *(u32x4*)(dst + (long)map(c0 + c) * ld_dst + dst_col0 + r0 + r8) = w;
    }
    __syncthreads();
}
struct MapId { DI int operator()(int c) const { return c; } };
struct MapOff { int off; DI int operator()(int c) const { return c + off; } };
struct MapGU { int up; DI int operator()(int c) const { return 32 * (c >> 4) + 16 * up + (c & 15); } };

DI void row_stats(const f32x4 (&v)[4], float& mean, float& rstd) {
    float s = 0.f;
#pragma unroll
    for (int i = 0; i < 4; ++i) s += (v[i][0] + v[i][1]) + (v[i][2] + v[i][3]);
    s = wave_sum(s); mean = s * (1.0f / 1024.0f);
    float q = 0.f;
#pragma unroll
    for (int i = 0; i < 4; ++i) { const f32x4 d = v[i] - mean; q += (d[0] * d[0] + d[1] * d[1]) + (d[2] * d[2] + d[3] * d[3]); }
    q = wave_sum(q); rstd = 1.0f / sqrtf(q * (1.0f / 1024.0f) + LN_EPS);
}

DI bool xcd_unit(int it, int NRT, int NCT, int& rt, int& ct) {
    const int G = gridDim.x;
    if (G & 7) { const int u = blockIdx.x + it * G; if (u >= NRT * NCT) return false; rt = u / NCT; ct = u - rt * NCT; return true; }
    const int nx = G >> 3, x = blockIdx.x & 7, j = blockIdx.x >> 3;
    const int NRTm = NRT & ~7, Lx = (NRTm >> 3) * NCT;
    const int v = j + it * nx;
    if (v < Lx) { const int i = v / NCT; ct = v - i * NCT; rt = x + 8 * i; return true; }
    int nmain = (Lx - j + nx - 1) / nx; if (nmain < 0) nmain = 0;
    const int w = x + 8 * ((j - Lx % nx + nx) % nx) + (it - nmain) * G;
    if (w >= (NRT - NRTm) * NCT) return false;
    const int i = w / NCT; rt = NRTm + i; ct = w - i * NCT; return true;
}

DI void phase_p0(const Params& p, unsigned char* smem) {
    unsigned char* ws = optr(p.ws);
    constexpr int U_WIN = 16 * 68, U_WUQ = 6 * 12, U_WK = 4 * 8, U_WV = 4 * 8, U_BOA = 8 * 16, U_BOB = 8 * 16, U_WOUT = 16 * 16, U_ADA = 96, U_ROUT = 48, U_ROPE = ((ROWS + 64) * 8 + NTHREADS - 1) / NTHREADS;
    constexpr int U_LAYER = U_WIN + U_WUQ + U_WK + U_WV + U_BOA + U_BOB + U_WOUT + U_ADA + U_ROUT;
    const int total = U_LAYER * DEPTH + U_ROPE;
    const int tid = otid();
    for (int u = blockIdx.x; u < total; u += gridDim.x) {
        if (u >= U_LAYER * DEPTH) {
            float* tab = (float*)(ws + WS_ROPE);
            for (int i = (u - U_LAYER * DEPTH) * NTHREADS + tid; i < (ROWS + 64) * 8; i += U_ROPE * NTHREADS) {
                const int pos = i >> 3, j = i & 7; const bool isrow = pos < ROWS; const int pv = isrow ? pos : pos - ROWS;
                const float inv = powf(10000.0f, -(float)(2 * j) / 16.0f);
                const float ang = (float)pv * inv;
                const double a = (double)ang;
                const float cs = (float)cos(a), sn = (float)sin(a);
                if (isrow) { tab[pv * 8 + j] = cs; tab[ROWS * 8 + pv * 8 + j] = sn; } else { tab[ROWS * 16 + pv * 8 + j] = cs; tab[ROWS * 16 + 512 + pv * 8 + j] = sn; }
            }
            continue;
        }
        const int l = u / U_LAYER; int v = u % U_LAYER;
        if (v < U_WIN) { transpose_tile(p.w_in + (size_t)l * 1024 * DIN, DIN, DIN, (v / 68) * 64, (v % 68) * 64, (bf16_t*)(ws + WS_WIN) + (size_t)l * DINP * 1024, 1024, 0, nullptr, MapId(), smem); continue; }
        v -= U_WIN;
        if (v < U_WUQ) { transpose_tile(p.w_uq + (size_t)l * 384 * 768, 768, 768, (v / 12) * 64, (v % 12) * 64, (bf16_t*)(ws + WS_WUQ) + (size_t)l * 768 * 384, 384, 0, p.g_qn + l * 384, MapId(), smem); continue; }
        v -= U_WUQ;
        if (v < U_WK) { transpose_tile(p.w_uk + (size_t)l * 256 * 512, 512, 512, (v / 8) * 64, (v % 8) * 64, (bf16_t*)(ws + WS_WKV) + (size_t)l * 1024 * 256, 256, 0, p.g_kvn + l * 256, MapId(), smem); continue; }
        v -= U_WK;
        if (v < U_WV) { transpose_tile(p.w_uv + (size_t)l * 256 * 512, 512, 512, (v / 8) * 64, (v % 8) * 64, (bf16_t*)(ws + WS_WKV) + (size_t)l * 1024 * 256, 256, 0, p.g_kvn + l * 256, MapOff{512}, smem); continue; }
        v -= U_WV;
        if (v < U_BOA) { transpose_tile(p.w_bo_mla + (size_t)l * 512 * 1024, 1024, 1024, (v / 16) * 64, (v % 16) * 64, (bf16_t*)(ws + WS_WBO) + (size_t)l * 1024 * 1024, 1024, 0, nullptr, MapId(), smem); continue; }
        v -= U_BOA;
        if (v < U_BOB) { transpose_tile(p.w_bo_mlstm + (size_t)l * 512 * 1024, 1024, 1024, (v / 16) * 64, (v % 16) * 64, (bf16_t*)(ws + WS_WBO) + (size_t)l * 1024 * 1024, 1024, 512, nullptr, MapId(), smem); continue; }
        v -= U_BOB;
        if (v < U_WOUT) { transpose_tile(p.w_out + (size_t)l * 1024 * 1024, 1024, 1024, (v / 16) * 64, (v % 16) * 64, (bf16_t*)(ws + WS_WOUT) + (size_t)l * 1024 * 1024, 1024, 0, nullptr, MapId(), smem); continue; }
        v -= U_WOUT;
        if (v < U_ADA) {
            const int lane = tid & 63, wave = tid >> 6, cg = lane & 15, kp = wave * 4 + (lane >> 4), col = v * 64 + cg * 4;
            const float* W = p.w_ada + (size_t)l * 1024 * 6144 + col;
            f32x4 al = (f32x4){0.f, 0.f, 0.f, 0.f}, ac = al;
#pragma unroll 16
            for (int k = kp * 64; k < kp * 64 + 64; ++k) {
                const f32x4 w = *(const f32x4*)(W + (size_t)k * 6144);
                const float sl = siluf_(p.c[k]), sc = siluf_(p.c_ctx[k]);
                al += w * sl; ac += w * sc;
            }
            f32x4* red = (f32x4*)smem;
            red[(kp * 2 + 0) * 16 + cg] = al; red[(kp * 2 + 1) * 16 + cg] = ac;
            __syncthreads();
            if (tid < 32) {
                const int s_ = tid >> 4, c_ = tid & 15;
                f32x4 s = red[s_ * 16 + c_];
#pragma unroll
                for (int q = 1; q < 16; ++q) s += red[(q * 2 + s_) * 16 + c_];
                s += *(const f32x4*)(p.b_ada + l * 6144 + v * 64 + c_ * 4);
                *(f32x4*)((float*)(ws + WS_MOD) + ((size_t)l * 2 + s_) * 6144 + v * 64 + c_ * 4) = s;
            }
            __syncthreads();
            continue;
        }
        v -= U_ADA;
        {
            bf16_t* RH = (bf16_t*)(ws + WS_ROUT) + (size_t)l * 2 * 48 * 1024; bf16_t* RL = RH + 48 * 1024;
            const int n = v;
#pragma unroll
            for (int k = tid; k < 1024; k += NTHREADS) {
                const float w = n < 4 ? p.w_rg[((size_t)l * 1024 + k) * 4 + n] : (n < 36 ? p.w_re[((size_t)l * 1024 + k) * 32 + (n - 4)] : 0.f);
                const bf16_t hi = f2bf(w); RH[n * 1024 + k] = hi; RL[n * 1024 + k] = f2bf(w - bf2f(hi));
            }
        }
    }
}

DI void store_hn(bf16_t* hn, long row, int lane, const f32x4 (&x)[4], const float* modv  ) {
    float mean, rstd; row_stats(x, mean, rstd);
#pragma unroll
    for (int i = 0; i < 4; ++i) {
        const int c = 4 * lane + 256 * i;
        const f32x4 sh = *(const f32x4*)(modv + c), sc = *(const f32x4*)(modv + 1024 + c);
        const f32x4 h = (x[i] - mean) * rstd * (sc + 1.0f) + sh;
        *(u32x2*)(hn + row * 1024 + c) = pack4(h);
    }
}
DI void phase_p1(const Params& p) {
    unsigned char* ws = optr(p.ws); const int tid_ = otid(), lane = tid_ & 63, wave = tid_ >> 6;
    bf16_t* X = (bf16_t*)(ws + WS_X); bf16_t* HN = (bf16_t*)(ws + WS_HN); const float* MOD = (const float*)(ws + WS_MOD);
    constexpr int RW = (T % 20 == 0) ? 5 : 4;
    for (int row0 = (blockIdx.x * 4 + wave) * RW; row0 < T; row0 += gridDim.x * 4 * RW) {
        f32x4 x[RW][4];
#pragma unroll
        for (int r = 0; r < RW; ++r) {
            const int row = row0 + r;
            const float* src = row < CTX ? p.ctx + (size_t)row * 1024 : p.x + (size_t)(row - CTX) * 1024;
#pragma unroll
            for (int i = 0; i < 4; ++i) x[r][i] = *(const f32x4*)(src + 4 * lane + 256 * i);
        }
#pragma unroll
        for (int r = 0; r < RW; ++r) {
            const int row = row0 + r;
#pragma unroll
            for (int i = 0; i < 4; ++i) *(u32x2*)(X + (size_t)row * 1024 + 4 * lane + 256 * i) = pack4h(x[r][i]);
            store_hn(HN, row, lane, x[r], MOD + (row < CTX ? 6144 : 0));
        }
    }
}
DI void phase_i(const Params& p, int l, int dry = 0) {
    unsigned char* ws = optr(p.ws); const int tid_ = otid(), lane = tid_ & 63, wave = tid_ >> 6;
    bf16_t* X = (bf16_t*)(ws + WS_X); bf16_t* XO = dry ? (bf16_t*)(ws + WS_P + (size_t)T * 4096 + 65536) : X; bf16_t* HN = (bf16_t*)(ws + (dry ? WS_CLOC : WS_HN)); const float* MOD = (const float*)(ws + WS_MOD);
    const bf16_t* MOE = (const bf16_t*)(ws + WS_MOE);
    const bool last = (l == DEPTH - 1);
    constexpr int RW = (T % 20 == 0) ? 5 : 4;
    for (int row0 = (blockIdx.x * 4 + wave) * RW; row0 < T; row0 += gridDim.x * 4 * RW) {
        if (last && row0 + RW <= CTX) continue;
        u32x2 xr[RW][4], m0[RW][4], m1[RW][4];
#pragma unroll
        for (int r = 0; r < RW; ++r)
#pragma unroll
            for (int i = 0; i < 4; ++i) {
                const int c = 4 * lane + 256 * i; const size_t row = (size_t)(row0 + r);
                xr[r][i] = *(const u32x2*)(X + row * 1024 + c);
                m0[r][i] = *(const u32x2*)(MOE + (row * 2 + 0) * 1024 + c); m1[r][i] = *(const u32x2*)(MOE + (row * 2 + 1) * 1024 + c);
            }
#pragma unroll
        for (int r = 0; r < RW; ++r) {
            const int row = row0 + r;
            if (last && row < CTX) continue;
            const float* modv = MOD + ((size_t)l * 2 + (row < CTX ? 1 : 0)) * 6144;
            f32x4 z[4];
#pragma unroll
            for (int i = 0; i < 4; ++i) {
                const int c = 4 * lane + 256 * i;
                const f32x4 xv = unpack4h(xr[r][i]);
                const f32x4 g2 = *(const f32x4*)(modv + 5 * 1024 + c);
                f32x4 mo;
                mo[0] = bf2f((bf16_t)(m0[r][i].x & 0xffff)) + bf2f((bf16_t)(m1[r][i].x & 0xffff)); mo[1] = bf2f((bf16_t)(m0[r][i].x >> 16)) + bf2f((bf16_t)(m1[r][i].x >> 16));
                mo[2] = bf2f((bf16_t)(m0[r][i].y & 0xffff)) + bf2f((bf16_t)(m1[r][i].y & 0xffff)); mo[3] = bf2f((bf16_t)(m0[r][i].y >> 16)) + bf2f((bf16_t)(m1[r][i].y >> 16));
                z[i] = xv * ALPHA + g2 * mo;
            }
            float mean, rstd; row_stats(z, mean, rstd);
#pragma unroll
            for (int i = 0; i < 4; ++i) {
                const int c = 4 * lane + 256 * i;
                const f32x4 g = *(const f32x4*)(p.ln2_g + l * 1024 + c), b = *(const f32x4*)(p.ln2_b + l * 1024 + c);
                z[i] = (z[i] - mean) * rstd * g + b;
                if (last) *(f32x4*)(p.out + (size_t)(row - CTX) * 1024 + c) = z[i];
                else *(u32x2*)(XO + (size_t)row * 1024 + c) = pack4h(z[i]);
            }
            if (!last) store_hn(HN, row, lane, z, MOD + ((size_t)(l + 1) * 2 + (row < CTX ? 1 : 0)) * 6144);
        }
    }
}

DI void phase_g(const Params& p, int l, unsigned char* smem, int dry = 0) {
    unsigned char* ws = optr(p.ws); const int tid_ = otid(), lane = tid_ & 63, wave = tid_ >> 6;
    bf16_t* X = (bf16_t*)(ws + WS_X); bf16_t* XO = dry ? (bf16_t*)(ws + WS_P + (size_t)T * 4096) : X; const bf16_t* ZB = (const bf16_t*)(ws + WS_ZB); bf16_t* HN = (bf16_t*)(ws + (dry ? WS_P + (size_t)T * 4096 + 65536 : WS_HN)); const float* MOD = (const float*)(ws + WS_MOD);
    const bf16_t* RH = (const bf16_t*)(ws + WS_ROUT) + (size_t)l * 2 * 48 * 1024; const bf16_t* RL = RH + 48 * 1024;
    unsigned* cnt = (unsigned*)(ws + WS_CNT) + (l * 2 + (dry ? 1 : 0)) * 2048; int* LIST = (int*)(ws + (dry ? WS_CLOC : WS_LIST)); float* LISTW = (float*)(ws + (dry ? WS_CLOC + (size_t)32 * T * 4 : WS_LISTW));
    constexpr int HST = 1032;
    bf16_t* hhi = (bf16_t*)smem; bf16_t* hlo = hhi + 16 * HST; float* lgs = (float*)(smem + 2 * 16 * HST * 2);
    const bool last = (l == DEPTH - 1);
    for (int row0 = (blockIdx.x * 4 + wave) * 4; row0 < T; row0 += gridDim.x * 16) {
        if (last && row0 < CTX) continue;
        const float* modv = MOD + ((size_t)l * 2 + (row0 < CTX ? 1 : 0)) * 6144;
        u32x2 zr[4][4];
#pragma unroll
        for (int r = 0; r < 4; ++r)
#pragma unroll
            for (int i = 0; i < 4; ++i) zr[r][i] = *(const u32x2*)(ZB + (size_t)(row0 + r) * 1024 + 4 * lane + 256 * i);
#pragma unroll
        for (int r = 0; r < 4; ++r) {
            const size_t row = (size_t)(row0 + r);
            f32x4 z[4];
#pragma unroll
            for (int i = 0; i < 4; ++i) z[i] = unpack4h(zr[r][i]);
            float mean, rstd; row_stats(z, mean, rstd);
#pragma unroll
            for (int i = 0; i < 4; ++i) {
                const int c = 4 * lane + 256 * i;
                const f32x4 g = *(const f32x4*)(p.ln1_g + l * 1024 + c), b = *(const f32x4*)(p.ln1_b + l * 1024 + c);
                z[i] = (z[i] - mean) * rstd * g + b;
                *(u32x2*)(XO + row * 1024 + c) = pack4h(z[i]);
            }
            row_stats(z, mean, rstd);
#pragma unroll
            for (int i = 0; i < 4; ++i) {
                const int c = 4 * lane + 256 * i;
                const f32x4 sh = *(const f32x4*)(modv + 3 * 1024 + c), sc = *(const f32x4*)(modv + 4 * 1024 + c);
                const f32x4 hv = (z[i] - mean) * rstd * (sc + 1.0f) + sh;
                const u32x2 hi = pack4(hv);
                *(u32x2*)(HN + row * 1024 + c) = hi;
                f32x4 d; d[0] = hv[0] - bf2f((bf16_t)(hi.x & 0xffff)); d[1] = hv[1] - bf2f((bf16_t)(hi.x >> 16)); d[2] = hv[2] - bf2f((bf16_t)(hi.y & 0xffff)); d[3] = hv[3] - bf2f((bf16_t)(hi.y >> 16));
                *(u32x2*)(hhi + (wave * 4 + r) * HST + c) = hi;
                *(u32x2*)(hlo + (wave * 4 + r) * HST + c) = pack4(d);
            }
        }
        __syncthreads();
        if (wave < 3) {
            const int fr = lane & 15, fq = lane >> 4;
            const bf16_t* rh = RH + (size_t)(wave * 16 + fr) * 1024 + 8 * fq; const bf16_t* rl = RL + (size_t)(wave * 16 + fr) * 1024 + 8 * fq;
            const bf16_t* bh = hhi + fr * HST + 8 * fq; const bf16_t* bl = hlo + fr * HST + 8 * fq;
            f32x4 a0 = (f32x4){0.f, 0.f, 0.f, 0.f}, a1 = a0, a2 = a0;
#pragma unroll 8
            for (int ks = 0; ks < 32; ++ks) {
                const bf16x8 ah = *(const bf16x8*)(rh + 32 * ks), al = *(const bf16x8*)(rl + 32 * ks);
                const bf16x8 xh = *(const bf16x8*)(bh + 32 * ks), xl = *(const bf16x8*)(bl + 32 * ks);
                a0 = MFMA16(ah, xh, a0); a1 = MFMA16(ah, xl, a1); a2 = MFMA16(al, xh, a2);
            }
            *(f32x4*)(lgs + fr * 48 + wave * 16 + 4 * fq) = a0 + (a1 + a2);
        }
        __syncthreads();
        float lg[4] = {0.f, 0.f, 0.f, 0.f};
        if (lane < 36) {
            const float bias = (lane < 4) ? p.b_rg[l * 4 + lane] : p.b_re[l * 32 + lane - 4];
#pragma unroll
            for (int r = 0; r < 4; ++r) lg[r] = lgs[(wave * 4 + r) * 48 + lane] + bias;
        }
#pragma unroll
        for (int r = 0; r < 4; ++r) {
            const float g0 = SHFL(lg[r], 0), g1 = SHFL(lg[r], 1), g2 = SHFL(lg[r], 2), g3 = SHFL(lg[r], 3);
            int grp = 0; float gm = g0;
            if (g1 > gm) { gm = g1; grp = 1; } if (g2 > gm) { gm = g2; grp = 2; } if (g3 > gm) { gm = g3; grp = 3; }
            const float pg = 1.0f / (__expf(g0 - gm) + __expf(g1 - gm) + __expf(g2 - gm) + __expf(g3 - gm));
            float e[8];
#pragma unroll
            for (int j = 0; j < 8; ++j) e[j] = SHFL(lg[r], 4 + grp * 8 + j);
            int i1 = 0; float m1 = e[0];
#pragma unroll
            for (int j = 1; j < 8; ++j) if (e[j] > m1) { m1 = e[j]; i1 = j; }
            int i2 = -1; float m2 = -3.0e38f;
#pragma unroll
            for (int j = 0; j < 8; ++j) if (j != i1 && e[j] > m2) { m2 = e[j]; i2 = j; }
            const float rr = __expf(m2 - m1), w1 = pg / (1.0f + rr), w2 = pg * rr / (1.0f + rr);
            if (lane == 0 && dry != 3) {
                const int row = row0 + r, e1 = grp * 8 + i1, e2 = grp * 8 + i2;
                const unsigned p1 = atomicAdd(&cnt[e1 * 64], 1u), p2 = atomicAdd(&cnt[e2 * 64], 1u);
                LIST[(size_t)e1 * T + p1] = row * 2 + 0; LISTW[(size_t)e1 * T + p1] = w1;
                LIST[(size_t)e2 * T + p2] = row * 2 + 1; LISTW[(size_t)e2 * T + p2] = w2;
            }
        }
    }
}

DI void phase_a(const Params& p, int l, unsigned char* smem) {
    unsigned char* ws = optr(p.ws); const int tid_ = otid(), lane = tid_ & 63, wave = tid_ >> 6, wr = wave >> 1, wc = wave & 1, fr = lane & 15, fq = lane >> 4;
    const bf16_t* HN = (const bf16_t*)(ws + WS_HN); const bf16_t* W = (const bf16_t*)(ws + WS_WIN) + (size_t)l * DINP * 1024;
    bf16_t* P = (bf16_t*)(ws + WS_P); bf16_t* PKT = (bf16_t*)(ws + WS_PKT); bf16_t* PVT = (bf16_t*)(ws + WS_PVT); float* GATES = (float*)(ws + WS_GATES);
    { int rt, ct; bool have = xcd_unit(0, RTT, 34, rt, ct), pre = false;
    for (int it = 0; have; ++it) {
        int nrt = 0, nct = 0; const bool hn = xcd_unit(it + 1, RTT, 34, nrt, nct);
        {
            f32x4 acc[MIT][4]; acc_zero(acc);
            gemm_chain(acc, RowsPlain{HN + (size_t)rt * TR * 1024, 1024}, W + (size_t)ct * 128 * 1024, 1024, 1024, smem, pre, hn, RowsPlain{HN + (size_t)nrt * TR * 1024, 1024}, W + (size_t)nct * 128 * 1024, 1024);
#pragma unroll
            for (int mi = 0; mi < MIT; ++mi) {
                const int row = rt * TR + wr * (TR / 2) + mi * 16 + fr;
                if (ct < 5) {
                    float q = 0.f;
#pragma unroll
                    for (int ni = 0; ni < 4; ++ni) { const f32x4 v = acc[mi][ni]; q += (v[0] * v[0] + v[1] * v[1]) + (v[2] * v[2] + v[3] * v[3]); }
                    q += SHFL_XOR(q, 16); q += SHFL_XOR(q, 32);
                    if (fq == 0) ((float*)(ws + WS_SSQ))[(size_t)row * 16 + ct * 2 + wc] = q;
                }
#pragma unroll
                for (int ni = 0; ni < 4; ni += 2)
                    *(u32x4*)(P + (size_t)row * DINP + ct * 128 + wc * 64 + widen_col(ni, lane)) = widen_pair(pack4(acc[mi][ni]), pack4(acc[mi][ni + 1]), lane);
#pragma unroll
                for (int ni = 0; ni < 4; ++ni) {
                    const int c0 = ct * 128 + wc * 64 + ni * 16, c = c0 + 4 * fq;
                    const f32x4 v = acc[mi][ni];
                    if (c0 >= C_PK && c0 < C_PV) {
                        *(u32x2*)(PKT + (size_t)(c - C_PK + (lane & 3)) * T + (row & ~3)) = pack4(quad_transpose(v, lane));
                    } else if (c0 >= C_PV && c0 < C_PO) {
                        *(u32x2*)(PVT + (size_t)(c - C_PV + (lane & 3)) * T + (row & ~3)) = pack4(quad_transpose(v, lane));
                    } else if (c0 == C_PG) {
                        *(f32x4*)(GATES + (size_t)row * 16 + 4 * fq) = v;
                    }
                }
            }
        }
        rt = nrt; ct = nct; have = hn; pre = hn;
    } }
}

DI void rope_angles(const float* tab, int t, int j, bool colpart, float& cs, float& sn) {
    if (t < CTX) { cs = 1.f; sn = 0.f; return; }
    const int s = t - CTX, ri = s >> 6, ci = s & 63;
    if (!colpart) { cs = tab[ri * 8 + j]; sn = tab[ROWS * 8 + ri * 8 + j]; } else { cs = tab[ROWS * 16 + ci * 8 + j]; sn = tab[ROWS * 16 + 512 + ci * 8 + j]; }
}
DI void phase_b(const Params& p, int l, unsigned char* smem) {
    unsigned char* ws = optr(p.ws); const int tid = otid(), lane = tid & 63, wave = tid >> 6, wr = wave >> 1, wc = wave & 1, fr = lane & 15, fq = lane >> 4;
    const bf16_t* P = (const bf16_t*)(ws + WS_P); const float* tab = (const float*)(ws + WS_ROPE);
    bf16_t* QB = (bf16_t*)(ws + WS_QB); bf16_t* KB = (bf16_t*)(ws + WS_KB); bf16_t* VT = (bf16_t*)(ws + WS_VT);
    constexpr int NQ = RT * 6, NKV = RTT * 8, NML = 4 * NB;
#ifndef PB_MASK
#define PB_MASK 7
#endif
    if (PB_MASK & 1)
    { int rt, ct;
    for (int it = 0; xcd_unit(it, RT, 6, rt, ct); ++it) {
        {
            f32x4 acc[4][4]; float ss[4]; acc_zero(acc);
            gemm_main<false>(acc, ss, RowsPlain{P + (size_t)rt * 128 * DINP + C_PQD, DINP}, (const bf16_t*)(ws + WS_WUQ) + (size_t)l * 768 * 384 + (size_t)ct * 128 * 384, 384, 384, smem);
#pragma unroll
            for (int mi = 0; mi < 4; ++mi) {
                const int row = rt * 128 + wr * 64 + mi * 16 + fr;
                const float* sq = (const float*)(ws + WS_SSQ) + (size_t)row * 16;
                const float rs = QSCALE / sqrtf((((sq[0] + sq[1]) + (sq[2] + sq[3])) + (sq[4] + sq[5])) * (1.0f / 384.0f) + LN_EPS);
                u32x2 qp[4];
#pragma unroll
                for (int ni = 0; ni < 4; ++ni) {
                    const int c0 = ct * 128 + wc * 64 + ni * 16, d0 = c0 % 96;
                    f32x4 v = acc[mi][ni] * rs;
                    if (d0 >= 64) {
                        f32x4 o;
#pragma unroll
                        for (int r = 0; r < 4; ++r) {
                            const float pr = SHFL_XOR(v[r], 32);
                            const int i = 4 * fq + r; float cs, sn; rope_angles(tab, row, i & 7, d0 >= 80, cs, sn);
                            o[r] = (i < 8) ? (v[r] * cs - pr * sn) : (v[r] * cs + pr * sn);
                        }
                        v = o;
                    }
                    qp[ni] = pack4(v);
                }
#pragma unroll
                for (int ni = 0; ni < 4; ni += 2) *(u32x4*)(QB + (size_t)row * 768 + ct * 128 + wc * 64 + widen_col(ni, lane)) = widen_pair(qp[ni], qp[ni + 1], lane);
            }
        }
    } }
    if (PB_MASK & 2)
    { int rt, ct;
    for (int it = 0; xcd_unit(it, RTT, 8, rt, ct); ++it) {
        {
            f32x4 acc[MIT][4]; float ss[4]; acc_zero(acc);
            gemm_main<false>(acc, ss, RowsPlain{P + (size_t)rt * TR * DINP + C_PKV, DINP}, (const bf16_t*)(ws + WS_WKV) + (size_t)l * 1024 * 256 + (size_t)ct * 128 * 256, 256, 256, smem);
#pragma unroll
            for (int mi = 0; mi < MIT; ++mi) {
                const int row = rt * TR + wr * (TR / 2) + mi * 16 + fr;
                const float* sq = (const float*)(ws + WS_SSQ) + (size_t)row * 16;
                const float rs = 1.0f / sqrtf(((sq[6] + sq[7]) + (sq[8] + sq[9])) * (1.0f / 256.0f) + LN_EPS);
                u32x2 kp[4] = {(u32x2){0u, 0u}, (u32x2){0u, 0u}, (u32x2){0u, 0u}, (u32x2){0u, 0u}};
#pragma unroll
                for (int ni = 0; ni < 4; ++ni) {
                    const int c = ct * 128 + wc * 64 + ni * 16 + 4 * fq;
                    const f32x4 v = acc[mi][ni] * rs;
                    if (c < 512) { kp[ni] = pack4(v); }
                    else {
                        *(u32x2*)(VT + (size_t)(c - 512 + (lane & 3)) * T + ((row & ~15) | ((row & 4) << 1) | ((row & 8) >> 1))) = pack4(quad_transpose(v, lane));
                    }
                }
                if (ct < 4) {
#pragma unroll
                    for (int ni = 0; ni < 4; ni += 2) *(u32x4*)(KB + (size_t)row * 768 + (ct * 2 + wc) * 96 + widen_col(ni, lane)) = widen_pair(kp[ni], kp[ni + 1], lane);
                }
            }
            if (ct == 0)
            for (int rr = tid >> 1; rr < TR; rr += NTHREADS / 2) {
                const int row = rt * TR + rr, g = tid & 1;
                const bf16_t* src = P + (size_t)row * DINP + C_KR + g * 16;
                const u32x4 a = *(const u32x4*)src, b = *(const u32x4*)(src + 8);
                float x[16];
                x[0] = bf2f(a.x & 0xffff); x[1] = bf2f(a.x >> 16); x[2] = bf2f(a.y & 0xffff); x[3] = bf2f(a.y >> 16); x[4] = bf2f(a.z & 0xffff); x[5] = bf2f(a.z >> 16); x[6] = bf2f(a.w & 0xffff); x[7] = bf2f(a.w >> 16);
                x[8] = bf2f(b.x & 0xffff); x[9] = bf2f(b.x >> 16); x[10] = bf2f(b.y & 0xffff); x[11] = bf2f(b.y >> 16); x[12] = bf2f(b.z & 0xffff); x[13] = bf2f(b.z >> 16); x[14] = bf2f(b.w & 0xffff); x[15] = bf2f(b.w >> 16);
                float o[16];
#pragma unroll
                for (int j = 0; j < 8; ++j) { float cs, sn; rope_angles(tab, row, j, g == 1, cs, sn); o[j] = x[j] * cs - x[j + 8] * sn; o[j + 8] = x[j + 8] * cs + x[j] * sn; }
                u32x4 w0, w1; w0.x = pack2(o[0], o[1]); w0.y = pack2(o[2], o[3]); w0.z = pack2(o[4], o[5]); w0.w = pack2(o[6], o[7]); w1.x = pack2(o[8], o[9]); w1.y = pack2(o[10], o[11]); w1.z = pack2(o[12], o[13]); w1.w = pack2(o[14], o[15]);
#pragma unroll
                for (int h = 0; h < 8; ++h) { bf16_t* dst = KB + (size_t)row * 768 + h * 96 + 64 + g * 16; *(u32x4*)dst = w0; *(u32x4*)(dst + 8) = w1; }
            }
        }
    } }
    if (PB_MASK & 4)
    for (int u = (blockIdx.x + gridDim.x - ((gridDim.x * 5) >> 3)) % gridDim.x; u < NML; u += gridDim.x) {
        {
            const int v0 = u, h = v0 / NB, tb = v0 % NB, dir = wave >> 1, dt = wave & 1, hh = lane >> 5, r31 = lane & 31;
            const float* GATES = (const float*)(ws + WS_GATES); const float* bg = p.b_gates + l * 16;
            const bf16_t* PKT = (const bf16_t*)(ws + WS_PKT); const bf16_t* PVT = (const bf16_t*)(ws + WS_PVT);
            float* wsb = (float*)smem + wave * 64;
            u32x4 kkr[4]; bf16x8 afr[4][4];
#pragma unroll
            for (int ks = 0; ks < 4; ++ks) kkr[ks] = *(const u32x4*)(PKT + (size_t)(h * 64 + dt * 32 + r31) * T + tb * 64 + 16 * ks + 8 * hh);
#pragma unroll
            for (int vt = 0; vt < 4; ++vt)
#pragma unroll
                for (int ks = 0; ks < 4; ++ks) afr[vt][ks] = *(const bf16x8*)(PVT + (size_t)(h * 128 + vt * 32 + r31) * T + tb * 64 + 16 * ks + 8 * hh);
            const int tau = dir ? 63 - lane : lane, t = tb * 64 + tau;
            const float ig = GATES[(size_t)t * 16 + (2 * dir) * 4 + h] + bg[(2 * dir) * 4 + h];
            const float lf = logsigmoidf_(GATES[(size_t)t * 16 + (2 * dir + 1) * 4 + h] + bg[(2 * dir + 1) * 4 + h]);
            const float b = scan_sum(lf, lane), bl = SHFL(b, 63);
            const float wlog = bl - b + ig, a = wave_max(wlog);
            wsb[tau] = __expf(wlog - a);
            const size_t sidx = ((size_t)(dir * 4 + h) * NB + tb);
            if (dt == 0 && lane == 0) { float* BLA = (float*)(ws + WS_BLA); BLA[sidx * 2 + 0] = bl; BLA[sidx * 2 + 1] = a; }
            __syncthreads();
            bf16x8 bfr[4]; float nl = 0.f;
#pragma unroll
            for (int ks = 0; ks < 4; ++ks) {
                const u32x4 kk = kkr[ks];
                const float* w8 = wsb + 16 * ks + 8 * hh;
                float f[8];
                f[0] = bf2f(kk.x & 0xffff) * w8[0]; f[1] = bf2f(kk.x >> 16) * w8[1]; f[2] = bf2f(kk.y & 0xffff) * w8[2]; f[3] = bf2f(kk.y >> 16) * w8[3];
                f[4] = bf2f(kk.z & 0xffff) * w8[4]; f[5] = bf2f(kk.z >> 16) * w8[5]; f[6] = bf2f(kk.w & 0xffff) * w8[6]; f[7] = bf2f(kk.w >> 16) * w8[7];
                nl += ((f[0] + f[1]) + (f[2] + f[3])) + ((f[4] + f[5]) + (f[6] + f[7]));
                u32x4 pk; pk.x = pack2(f[0], f[1]); pk.y = pack2(f[2], f[3]); pk.z = pack2(f[4], f[5]); pk.w = pack2(f[6], f[7]);
                bfr[ks] = __builtin_bit_cast(bf16x8, pk);
            }
            nl += SHFL_XOR(nl, 32);
            if (hh == 0) ((float*)(ws + WS_NLOC))[sidx * 64 + dt * 32 + r31] = nl;
            float* CL = (float*)(ws + WS_CLOC) + sidx * 8192;
#pragma unroll
            for (int vt = 0; vt < 4; ++vt) {
                f32x16 c;
#pragma unroll
                for (int r = 0; r < 16; ++r) c[r] = 0.f;
#pragma unroll
                for (int ks = 0; ks < 4; ++ks) {
                    c = MFMA32(afr[vt][ks], bfr[ks], c);
                }
#pragma unroll
                for (int r = 0; r < 16; ++r) CL[(vt * 32 + crow(r, hh)) * 64 + dt * 32 + r31] = c[r];
            }
            __syncthreads();
        }
    }
}

DI void attn_unit(const Params& p, int q0, int h, int nkeys, unsigned char* smem) {
    unsigned char* ws = optr(p.ws); const int tid = otid(), lane = tid & 63, wave = tid >> 6, hh = lane >> 5, r31 = lane & 31;
    const bf16_t* QB = (const bf16_t*)(ws + WS_QB); const bf16_t* KB = (const bf16_t*)(ws + WS_KB); const bf16_t* VT = (const bf16_t*)(ws + WS_VT); bf16_t* O = (bf16_t*)(ws + WS_O);
    bf16x8 qf[2][6];
#pragma unroll
    for (int qi = 0; qi < 2; ++qi)
#pragma unroll
        for (int ks = 0; ks < 6; ++ks) qf[qi][ks] = *(const bf16x8*)(QB + (size_t)(q0 + wave * 64 + qi * 32 + r31) * 768 + h * 96 + 16 * ks + 8 * hh);
    f32x16 o[2][2]; float mref[2], lsum[2]; bf16x8 biasB[2];
    const bf16x8 onesA = __builtin_bit_cast(bf16x8, (u32x4){hh == 0 ? 0x3F80u : 0u, 0u, 0u, 0u});
    const f32x16 zero16 = {0.f, 0.f, 0.f, 0.f, 0.f, 0.f, 0.f, 0.f, 0.f, 0.f, 0.f, 0.f, 0.f, 0.f, 0.f, 0.f};
#pragma unroll
    for (int qi = 0; qi < 2; ++qi) { mref[qi] = 0.f; lsum[qi] = 0.f; biasB[qi] = __builtin_bit_cast(bf16x8, (u32x4){0u, 0u, 0u, 0u});
#pragma unroll
        for (int vt = 0; vt < 2; ++vt) o[qi][vt] = zero16; }
    const bf16_t* kg = KB + h * 96; const bf16_t* vg = VT + (size_t)h * 64 * T;
    bf16_t* sb = (bf16_t*)smem;
    const int ksw = (r31 >> 2) & 3, vsw = (r31 >> 1) & 7;
    const unsigned laneK = (r31 >> 4) * 3072 + (r31 & 15) * 64 + ((hh ^ ksw) & 3) * 16, laneV = 12288 + r31 * 128 + ((hh ^ vsw) & 7) * 16;
#define ATTN_KF(B, SUB, KS) (*(const bf16x8*)((B) + ((laneK ^ (((KS) & 1) * 32)) + (SUB) * 6144 + ((KS) >> 1) * 1024)))
#define ATTN_VF(B, SUB, S2, VTI) (*(const bf16x8*)((B) + ((laneV ^ ((SUB) * 64 + (S2) * 32)) + (VTI) * 4096)))
#define ATTN_ISSUE(KT, BUF) do { unsigned char* base_ = smem + (BUF) * 20480; const unsigned l2_ = (unsigned)otid() & 63u; \
        const unsigned kofs_ = ((16u * wave + (l2_ >> 2)) * 768u + ((l2_ & 3u) ^ ((l2_ >> 4) & 3u)) * 8u) * 2u; \
        const unsigned vofs_ = ((16u * wave + (l2_ >> 3)) * (unsigned)T + ((l2_ & 7u) ^ (l2_ >> 4)) * 8u) * 2u; \
        const unsigned char* kt_ = (const unsigned char*)kg + (size_t)(KT) * (64 * 768 * 2); const unsigned char* vt_ = (const unsigned char*)vg + (size_t)(KT) * 128; \
        _Pragma("unroll") for (int g = 0; g < 3; ++g) GLDS16(kt_ + g * 64 + kofs_, base_ + (wave * 3 + g) * 1024); \
        GLDS16(vt_ + vofs_, base_ + 12288 + (wave * 2) * 1024); \
        GLDS16(vt_ + (size_t)8 * T * 2 + (vofs_ ^ 64u), base_ + 12288 + (wave * 2 + 1) * 1024); } while (0)
    ATTN_ISSUE(0, 0);
    const int nt = nkeys >> 6;
    WAIT_VM0(); __syncthreads();
    if (nt > 1) ATTN_ISSUE(1, 1);
    bool hasb;
    {
        const unsigned char* Bs = smem;
        f32x16 s[2] = {zero16, zero16};
#pragma unroll
        for (int ks = 0; ks < 6; ++ks) {
            const bf16x8 kf = ATTN_KF(Bs, 0, ks);
            s[0] = MFMA32(kf, qf[0][ks], s[0]); s[1] = MFMA32(kf, qf[1][ks], s[1]);
        }
#pragma unroll
        for (int qi = 0; qi < 2; ++qi) {
            float mx = s[qi][0];
#pragma unroll
            for (int r = 1; r < 16; ++r) mx = fmaxf(mx, s[qi][r]);
            mx = fmaxf(mx, SHFL_XOR(mx, 32));
            unsigned ub = __builtin_bit_cast(unsigned, mx); unsigned tb = ub & 0xFFFF0000u; if (mx > 0.f && (ub & 0xFFFFu)) tb += 0x10000u;
            mref[qi] = (mx > ATTN_REFHI || mx < ATTN_REFLO) ? __builtin_bit_cast(float, tb) : 0.f;
            const unsigned nb = (__builtin_bit_cast(unsigned, -mref[qi])) >> 16;
            biasB[qi] = __builtin_bit_cast(bf16x8, (u32x4){hh == 0 ? nb : 0u, 0u, 0u, 0u});
        }
        hasb = WAVE_ANY(mref[0] != 0.f || mref[1] != 0.f);
    }
    int kt = 0;
    while (kt < nt && !hasb) {
        const unsigned char* Bs = smem + (kt & 1) * 20480;
        float rsm = 0.f;
#pragma unroll
        for (int sub = 0; sub < 2; ++sub) {
            f32x16 s0 = zero16, s1 = zero16;
#pragma unroll
            for (int ks = 0; ks < 6; ++ks) {
                const bf16x8 kf = ATTN_KF(Bs, sub, ks);
                s0 = MFMA32(kf, qf[0][ks], s0); s1 = MFMA32(kf, qf[1][ks], s1);
            }
            float rs0 = 0.f; bf16x8 pf0[2];
            {
#pragma unroll
                for (int r = 0; r < 16; ++r) { const float e = EXP2F(s0[r]); s0[r] = e; rs0 += e; NOSLP(rs0); }
#pragma unroll
                for (int s2 = 0; s2 < 2; ++s2) { u32x4 pk; pk.x = pack2(s0[8 * s2 + 0], s0[8 * s2 + 1]); pk.y = pack2(s0[8 * s2 + 2], s0[8 * s2 + 3]); pk.z = pack2(s0[8 * s2 + 4], s0[8 * s2 + 5]); pk.w = pack2(s0[8 * s2 + 6], s0[8 * s2 + 7]); pf0[s2] = __builtin_bit_cast(bf16x8, pk); }
            }
#pragma unroll
            for (int vt = 0; vt < 2; ++vt)
#pragma unroll
                for (int s2 = 0; s2 < 2; ++s2) {
                    o[0][vt] = MFMA32(ATTN_VF(Bs, sub, s2, vt), pf0[s2], o[0][vt]);
                }
            float rs1 = 0.f; bf16x8 pf1[2];
            {
#pragma unroll
                for (int r = 0; r < 16; ++r) { const float e = EXP2F(s1[r]); s1[r] = e; rs1 += e; NOSLP(rs1); }
#pragma unroll
                for (int s2 = 0; s2 < 2; ++s2) { u32x4 pk; pk.x = pack2(s1[8 * s2 + 0], s1[8 * s2 + 1]); pk.y = pack2(s1[8 * s2 + 2], s1[8 * s2 + 3]); pk.z = pack2(s1[8 * s2 + 4], s1[8 * s2 + 5]); pk.w = pack2(s1[8 * s2 + 6], s1[8 * s2 + 7]); pf1[s2] = __builtin_bit_cast(bf16x8, pk); }
            }
#pragma unroll
            for (int vt = 0; vt < 2; ++vt)
#pragma unroll
                for (int s2 = 0; s2 < 2; ++s2) {
                    o[1][vt] = MFMA32(ATTN_VF(Bs, sub, s2, vt), pf1[s2], o[1][vt]);
                }
            lsum[0] += rs0; lsum[1] += rs1; rsm = fmaxf(rsm, fmaxf(rs0, rs1));
        }
        if (WAVE_ANY(!(rsm < ATTN_BIG))) {
            hasb = true;
            const float rm = fmaxf(rsm, SHFL_XOR(rsm, 32));
            if (rm >= ATTN_BIG) {
                const float d = (float)((int)((__builtin_bit_cast(unsigned, rm) >> 23) & 0xFF) - 126);
#pragma unroll
                for (int qi = 0; qi < 2; ++qi) {
                    const float mt = mref[qi] + d;
                    unsigned ub = __builtin_bit_cast(unsigned, mt); unsigned tb = ub & 0xFFFF0000u; if (mt > 0.f && (ub & 0xFFFFu)) tb += 0x10000u;
                    const float mn = __builtin_bit_cast(float, tb), al = EXP2F(mref[qi] - mn);
                    lsum[qi] *= al;
#pragma unroll
                    for (int vt = 0; vt < 2; ++vt) o[qi][vt] *= al;
                    mref[qi] = mn;
                    const unsigned nb = (__builtin_bit_cast(unsigned, -mn)) >> 16;
                    biasB[qi] = __builtin_bit_cast(bf16x8, (u32x4){hh == 0 ? nb : 0u, 0u, 0u, 0u});
                }
            }
        }
        ++kt;
        if (kt < nt) { WAIT_VM0(); __syncthreads(); if (kt + 1 < nt) ATTN_ISSUE(kt + 1, (kt + 1) & 1); }
    }
    while (kt < nt) {
        const unsigned char* Bs = smem + (kt & 1) * 20480;
        float rsm = 0.f;
#pragma unroll
        for (int sub = 0; sub < 2; ++sub) {
            f32x16 s0 = MFMA32(onesA, biasB[0], zero16), s1 = MFMA32(onesA, biasB[1], zero16);
#pragma unroll
            for (int ks = 0; ks < 6; ++ks) {
                const bf16x8 kf = ATTN_KF(Bs, sub, ks);
                s0 = MFMA32(kf, qf[0][ks], s0); s1 = MFMA32(kf, qf[1][ks], s1);
            }
            float rs0 = 0.f; bf16x8 pf0[2];
            {
#pragma unroll
                for (int r = 0; r < 16; ++r) { const float e = EXP2F(s0[r]); s0[r] = e; rs0 += e; NOSLP(rs0); }
#pragma unroll
                for (int s2 = 0; s2 < 2; ++s2) { u32x4 pk; pk.x = pack2(s0[8 * s2 + 0], s0[8 * s2 + 1]); pk.y = pack2(s0[8 * s2 + 2], s0[8 * s2 + 3]); pk.z = pack2(s0[8 * s2 + 4], s0[8 * s2 + 5]); pk.w = pack2(s0[8 * s2 + 6], s0[8 * s2 + 7]); pf0[s2] = __builtin_bit_cast(bf16x8, pk); }
            }
#pragma unroll
            for (int vt = 0; vt < 2; ++vt)
#pragma unroll
                for (int s2 = 0; s2 < 2; ++s2) {
                    o[0][vt] = MFMA32(ATTN_VF(Bs, sub, s2, vt), pf0[s2], o[0][vt]);
                }
            float rs1 = 0.f; bf16x8 pf1[2];
            {
#pragma unroll
                for (int r = 0; r < 16; ++r) { const float e = EXP2F(s1[r]); s1[r] = e; rs1 += e; NOSLP(rs1); }
#pragma unroll
                for (int s2 = 0; s2 < 2; ++s2) { u32x4 pk; pk.x = pack2(s1[8 * s2 + 0], s1[8 * s2 + 1]); pk.y = pack2(s1[8 * s2 + 2], s1[8 * s2 + 3]); pk.z = pack2(s1[8 * s2 + 4], s1[8 * s2 + 5]); pk.w = pack2(s1[8 * s2 + 6], s1[8 * s2 + 7]); pf1[s2] = __builtin_bit_cast(bf16x8, pk); }
            }
#pragma unroll
            for (int vt = 0; vt < 2; ++vt)
#pragma unroll
                for (int s2 = 0; s2 < 2; ++s2) {
                    o[1][vt] = MFMA32(ATTN_VF(Bs, sub, s2, vt), pf1[s2], o[1][vt]);
                }
            lsum[0] += rs0; lsum[1] += rs1; rsm = fmaxf(rsm, fmaxf(rs0, rs1));
        }
        if (WAVE_ANY(!(rsm < ATTN_BIG))) {
            hasb = true;
            const float rm = fmaxf(rsm, SHFL_XOR(rsm, 32));
            if (rm >= ATTN_BIG) {
                const float d = (float)((int)((__builtin_bit_cast(unsigned, rm) >> 23) & 0xFF) - 126);
#pragma unroll
                for (int qi = 0; qi < 2; ++qi) {
                    const float mt = mref[qi] + d;
                    unsigned ub = __builtin_bit_cast(unsigned, mt); unsigned tb = ub & 0xFFFF0000u; if (mt > 0.f && (ub & 0xFFFFu)) tb += 0x10000u;
                    const float mn = __builtin_bit_cast(float, tb), al = EXP2F(mref[qi] - mn);
                    lsum[qi] *= al;
#pragma unroll
                    for (int vt = 0; vt < 2; ++vt) o[qi][vt] *= al;
                    mref[qi] = mn;
                    const unsigned nb = (__builtin_bit_cast(unsigned, -mn)) >> 16;
                    biasB[qi] = __builtin_bit_cast(bf16x8, (u32x4){hh == 0 ? nb : 0u, 0u, 0u, 0u});
                }
            }
        }
        ++kt;
        if (kt < nt) { WAIT_VM0(); __syncthreads(); if (kt + 1 < nt) ATTN_ISSUE(kt + 1, (kt + 1) & 1); }
    }
    __syncthreads();
#undef ATTN_ISSUE
#undef ATTN_KF
#undef ATTN_VF
#pragma unroll
    for (int qi = 0; qi < 2; ++qi) {
        const float lt = lsum[qi] + SHFL_XOR(lsum[qi], 32), inv = 1.0f / lt;
        const size_t row = (size_t)(q0 + wave * 64 + qi * 32 + r31);
#pragma unroll
        for (int vt = 0; vt < 2; ++vt)
#pragma unroll
            for (int g = 0; g < 4; ++g) {
                f32x4 v; v[0] = o[qi][vt][4 * g] * inv; v[1] = o[qi][vt][4 * g + 1] * inv; v[2] = o[qi][vt][4 * g + 2] * inv; v[3] = o[qi][vt][4 * g + 3] * inv;
                *(u32x2*)(O + row * 512 + h * 64 + vt * 32 + 8 * g + 4 * hh) = pack4(v);
            }
    }
}
DI int chain_tb(int dir, int c) { return dir == 0 ? c : (c < NCB ? NCB - 1 - c : NB - 1 - (c - NCB)); }
DI void scan_unit(const Params& p, int su, unsigned char* smem) {
    constexpr int SB = (NB % 13 == 0) ? 13 : 4;
    static_assert(NB % SB == 0, "scan batch");
    unsigned char* ws = optr(p.ws); const int tid = otid();
    const bool isn = su >= 64;
    const int dh = isn ? su - 64 : su >> 3, part = su & 7, dir = dh >> 2;
    float* sbla = (float*)smem; int* stb = (int*)(smem + 8 * NB);
    { const float* BLA = (const float*)(ws + WS_BLA);
      for (int i = tid; i < NB; i += NTHREADS) { const int tb = chain_tb(dir, i); stb[i] = tb; sbla[2 * i] = BLA[((size_t)dh * NB + tb) * 2]; sbla[2 * i + 1] = BLA[((size_t)dh * NB + tb) * 2 + 1]; } }
    __syncthreads();
    if (!isn || tid < 16) {
        const int stride = isn ? 64 : 8192;
        const float* SRC = isn ? (const float*)(ws + WS_NLOC) + (size_t)dh * NB * 64 + tid * 4 : (const float*)(ws + WS_CLOC) + (size_t)dh * NB * 8192 + (part * 256 + tid) * 4;
        bf16_t* CP = (bf16_t*)(ws + WS_CPREV) + (size_t)dh * NB * 8192 + (part * 256 + tid) * 4;
        float* NP = (float*)(ws + WS_NPREV) + (size_t)dh * NB * 64 + tid * 4;
        float* MPREV = (float*)(ws + WS_MPREV) + (size_t)dh * NB;
        f32x4 st = (f32x4){0.f, 0.f, 0.f, 0.f}; float m = 0.f;
        for (int c0 = 0; c0 < NB; c0 += SB) {
            f32x4 cl[SB];
#pragma unroll
            for (int j = 0; j < SB; ++j) cl[j] = *(const f32x4*)(SRC + (size_t)stb[c0 + j] * stride);
#pragma unroll
            for (int j = 0; j < SB; ++j) {
                const int tb = stb[c0 + j];
                if (isn) *(f32x4*)(NP + (size_t)tb * 64) = st; else *(u32x2*)(CP + (size_t)tb * 8192) = pack4(st);
                if (!isn && part == 0 && tid == 0) MPREV[tb] = m;
                const float bl = sbla[2 * (c0 + j)], a = sbla[2 * (c0 + j) + 1];
                const float mn = fmaxf(bl + m, a), fc = __expf(bl + m - mn), fl = __expf(a - mn);
                st = st * fc + cl[j] * fl; m = mn;
            }
        }
    }
    __syncthreads();
}
DI void phase_c(const Params& p, unsigned char* smem) {
    constexpr int NLQ = SEQ / 256, NCQ = CTX / 256, NATT = NLQ * 8, NSC = 72;
    for (int u = blockIdx.x; u < NLQ * 8; u += gridDim.x) attn_unit(p, CTX + (u >> 3) * 256, u & 7, T, smem);
    for (int u = (blockIdx.x + gridDim.x - (NATT % gridDim.x)) % gridDim.x; u < NSC; u += gridDim.x) scan_unit(p, u, smem);
}

constexpr int NCV = 32 * 192, NCV_D = 2880, NCV_E = 4512;
DI void convert_experts(const Params& p, int l, int lo, int hi, unsigned char* smem, bool dtail);
DI void phase_d(const Params& p, int l, unsigned char* smem) {
    unsigned char* ws = optr(p.ws); const int tid = otid(), lane = tid & 63, wave = tid >> 6, hh = lane >> 5, r31 = lane & 31, dir = wave >> 1, jt = wave & 1;
    const bf16_t* P = (const bf16_t*)(ws + WS_P); const bf16_t* PVT = (const bf16_t*)(ws + WS_PVT); const float* GATES = (const float*)(ws + WS_GATES); const float* bg = p.b_gates + l * 16;
    bf16_t* HM = (bf16_t*)(ws + WS_HM);
    float* gsm = (float*)smem + wave * 192;
    float* hx = (float*)(smem + 4096);
    for (int u = blockIdx.x; u < 4 * NB; u += gridDim.x) {
        const int h = u / NB, tb = u % NB, t0 = tb * 64;
        const size_t sidx = ((size_t)(dir * 4 + h) * NB + tb);
        const float mprev = ((const float*)(ws + WS_MPREV))[sidx];
        const int tj = jt * 32 + r31;
        const bf16_t* CP = (const bf16_t*)(ws + WS_CPREV) + sidx * 8192;
        bf16x8 qf[4], cfr[4][4], kfr[2][4];
#pragma unroll
        for (int ks = 0; ks < 4; ++ks) qf[ks] = *(const bf16x8*)(P + (size_t)(t0 + tj) * DINP + C_PQ + h * 64 + 16 * ks + 8 * hh);
#pragma unroll
        for (int vt = 0; vt < 4; ++vt)
#pragma unroll
            for (int ks = 0; ks < 4; ++ks) cfr[vt][ks] = *(const bf16x8*)(CP + (vt * 32 + r31) * 64 + 16 * ks + 8 * hh);
#pragma unroll
        for (int st = 0; st < 2; ++st)
#pragma unroll
            for (int ks = 0; ks < 4; ++ks) kfr[st][ks] = *(const bf16x8*)(P + (size_t)(t0 + st * 32 + r31) * DINP + C_PK + h * 64 + 16 * ks + 8 * hh);
        {
            const int tau = dir ? 63 - lane : lane, t = t0 + tau;
            const float ig = GATES[(size_t)t * 16 + (2 * dir) * 4 + h] + bg[(2 * dir) * 4 + h];
            const float lf = logsigmoidf_(GATES[(size_t)t * 16 + (2 * dir + 1) * 4 + h] + bg[(2 * dir + 1) * 4 + h]);
            const float b = scan_sum(lf, lane), uu = ig - b, pm = fmaxf(mprev, scan_max(uu, lane));
            gsm[tau] = uu; gsm[64 + tau] = b; gsm[128 + tau] = pm;
        }
        __syncthreads();
        const float pmj = gsm[128 + tj], bj = gsm[64 + tj], mj = bj + pmj, scj = __expf(mprev - pmj);
        f32x16 acc[4];
#pragma unroll
        for (int vt = 0; vt < 4; ++vt) {
#pragma unroll
            for (int r = 0; r < 16; ++r) acc[vt][r] = 0.f;
#pragma unroll
            for (int ks = 0; ks < 4; ++ks) acc[vt] = MFMA32(cfr[vt][ks], qf[ks], acc[vt]);
            acc[vt] *= (scj * 0.125f);
        }
        float qn = 0.f;
        {
            const float* NP = (const float*)(ws + WS_NPREV) + sidx * 64;
#pragma unroll
            for (int ks = 0; ks < 4; ++ks)
#pragma unroll
                for (int j = 0; j < 8; ++j) qn += bf2f((bf16_t)qf[ks][j]) * NP[16 * ks + 8 * hh + j];
            qn += SHFL_XOR(qn, 32);
        }
        float rowsum = 0.f;
#pragma unroll
        for (int st = 0; st < 2; ++st) {
            f32x16 s;
#pragma unroll
            for (int r = 0; r < 16; ++r) s[r] = 0.f;
#pragma unroll
            for (int ks = 0; ks < 4; ++ks) s = MFMA32(kfr[st][ks], qf[ks], s);
#pragma unroll
            for (int r = 0; r < 16; ++r) {
                const int ts = st * 32 + crow(r, hh);
                const bool ok = dir ? (ts >= tj) : (ts <= tj);
                const float w = ok ? __expf(gsm[ts] - pmj) : 0.f;
                s[r] = s[r] * 0.125f * w; rowsum += s[r];
            }
#pragma unroll
            for (int s2 = 0; s2 < 2; ++s2) {
                u32x4 pk; pk.x = pack2(s[8 * s2 + 0], s[8 * s2 + 1]); pk.y = pack2(s[8 * s2 + 2], s[8 * s2 + 3]); pk.z = pack2(s[8 * s2 + 4], s[8 * s2 + 5]); pk.w = pack2(s[8 * s2 + 6], s[8 * s2 + 7]);
                const bf16x8 pf = __builtin_bit_cast(bf16x8, pk);
#pragma unroll
                for (int vt = 0; vt < 4; ++vt) {
                    const bf16_t* va = PVT + (size_t)(h * 128 + vt * 32 + r31) * T + t0 + st * 32 + 16 * s2 + 4 * hh;
                    const u32x2 lo = *(const u32x2*)va, hi = *(const u32x2*)(va + 8);
                    u32x4 vv; vv.x = lo.x; vv.y = lo.y; vv.z = hi.x; vv.w = hi.y;
                    acc[vt] = MFMA32(__builtin_bit_cast(bf16x8, vv), pf, acc[vt]);
                }
            }
        }
        rowsum += SHFL_XOR(rowsum, 32);
        const float nq = rowsum + scj * 0.125f * qn;
        const float inv = 1.0f / fmaxf(fabsf(nq), __expf(-mj));
        if (dir == 1) {
#pragma unroll
            for (int vt = 0; vt < 4; ++vt)
#pragma unroll
                for (int r = 0; r < 16; ++r) hx[tj * 132 + vt * 32 + crow(r, hh)] = acc[vt][r] * inv;
        }
        __syncthreads();
        if (dir == 0) {
            float s1 = 0.f;
#pragma unroll
            for (int vt = 0; vt < 4; ++vt)
#pragma unroll
                for (int r = 0; r < 16; ++r) { const float v = acc[vt][r] * inv + hx[tj * 132 + vt * 32 + crow(r, hh)]; acc[vt][r] = v; s1 += v; }
            s1 += SHFL_XOR(s1, 32);
            const float mean = s1 * (1.0f / 128.0f);
            float s2 = 0.f;
#pragma unroll
            for (int vt = 0; vt < 4; ++vt)
#pragma unroll
                for (int r = 0; r < 16; ++r) { const float dlt = acc[vt][r] - mean; s2 += dlt * dlt; }
            s2 += SHFL_XOR(s2, 32);
            const float rstd = 1.0f / sqrtf(s2 * (1.0f / 128.0f) + LN_EPS);
#pragma unroll
            for (int vt = 0; vt < 4; ++vt)
#pragma unroll
                for (int r = 0; r < 16; ++r) hx[tj * 132 + vt * 32 + crow(r, hh)] = (acc[vt][r] - mean) * rstd;
        }
        __syncthreads();
        {
            const int tk = tid >> 2, qv = tid & 3; const size_t t = (size_t)(t0 + tk);
            const float* src = hx + tk * 132 + qv * 32; const bf16_t* po = P + t * DINP + C_PO + h * 128 + qv * 32; const float* gm = p.g_mh + l * 512 + h * 128 + qv * 32;
            bf16_t* dst = HM + t * 512 + h * 128 + qv * 32;
#pragma unroll
            for (int c = 0; c < 32; c += 8) {
                const u32x4 pw = *(const u32x4*)(po + c);
                float o8[8];
                const unsigned pws[4] = {pw.x, pw.y, pw.z, pw.w};
#pragma unroll
                for (int j = 0; j < 4; ++j) {
                    o8[2 * j] = src[c + 2 * j] * gm[c + 2 * j] * sigmoidf_(bf2f((bf16_t)(pws[j] & 0xffff)));
                    o8[2 * j + 1] = src[c + 2 * j + 1] * gm[c + 2 * j + 1] * sigmoidf_(bf2f((bf16_t)(pws[j] >> 16)));
                }
                u32x4 w; w.x = pack2(o8[0], o8[1]); w.y = pack2(o8[2], o8[3]); w.z = pack2(o8[4], o8[5]); w.w = pack2(o8[6], o8[7]);
                *(u32x4*)(dst + c) = w;
            }
        }
        __syncthreads();
    }
    {
        constexpr int NCQ8 = (CTX / 256) * 8;
        for (int u = (int)gridDim.x - 1 - (int)blockIdx.x; u < NCQ8; u += gridDim.x) attn_unit(p, (u >> 3) * 256, u & 7, CTX, smem);
    }
    convert_experts(p, l, 0, NCV_D, smem, true);
}

DI void convert_experts(const Params& p, int l, int lo, int hi, unsigned char* smem, bool dtail) {
    unsigned char* ws = optr(p.ws);
    const int G = gridDim.x;
    int idx = blockIdx.x, cnt = G;
    if (dtail) {
        const int left = (4 * NB) % G, top = (CTX / 256) * 8;
        if (left && left + top < G) { if ((int)blockIdx.x < left || (int)blockIdx.x >= G - top) return; idx = blockIdx.x - left; cnt = G - left - top; }
    } else if (!(G & 7)) {
        const int nx = G >> 3, Lx = ((RTT & ~7) >> 3) * 8, rem = Lx % nx, left = (RTT - (RTT & ~7)) * 8, j = blockIdx.x >> 3, x = blockIdx.x & 7;
        if (rem) { if (j < rem) return; idx = (j - rem) * 8 + x; cnt = (nx - rem) * 8; }
        else if (left && left < G) { if ((int)blockIdx.x < left) return; idx = blockIdx.x - left; cnt = G - left; }
    }
    for (int u = lo + idx; u < hi; u += cnt) {
        const int e = u / 192, w = u % 192;
        if (w < 64) transpose_tile(p.w_e_gate + ((size_t)l * 32 + e) * 1024 * 256, 256, 256, (w / 4) * 64, (w % 4) * 64, (bf16_t*)(ws + WS_WGU) + (size_t)e * 512 * 1024, 1024, 0, nullptr, MapGU{0}, smem);
        else if (w < 128) transpose_tile(p.w_e_up + ((size_t)l * 32 + e) * 1024 * 256, 256, 256, ((w - 64) / 4) * 64, ((w - 64) % 4) * 64, (bf16_t*)(ws + WS_WGU) + (size_t)e * 512 * 1024, 1024, 0, nullptr, MapGU{1}, smem);
        else transpose_tile(p.w_e_down + ((size_t)l * 32 + e) * 256 * 1024, 1024, 1024, ((w - 128) / 16) * 64, ((w - 128) % 16) * 64, (bf16_t*)(ws + WS_WD) + (size_t)e * 1024 * 256, 256, 0, nullptr, MapId(), smem);
    }
}

DI void phase_e(const Params& p, int l, unsigned char* smem) {
    unsigned char* ws = optr(p.ws); const int tid_ = otid(), lane = tid_ & 63, wave = tid_ >> 6, wr = wave >> 1, wc = wave & 1, fr = lane & 15, fq = lane >> 4;
    const bf16_t* P = (const bf16_t*)(ws + WS_P); const bf16_t* W = (const bf16_t*)(ws + WS_WBO) + (size_t)l * 1024 * 1024; bf16_t* U = (bf16_t*)(ws + WS_U);
    int rt, ct;
    for (int it = 0; xcd_unit(it, RTT, 8, rt, ct); ++it) {
        f32x4 acc[MIT][4]; u32x2 t1[MIT][4]; float ss[4]; acc_zero(acc);
        gemm_main<false>(acc, ss, RowsPlain{(const bf16_t*)(ws + WS_O) + (size_t)rt * TR * 512, 512}, W + (size_t)ct * 128 * 1024, 1024, 512, smem);
#pragma unroll
        for (int mi = 0; mi < MIT; ++mi) {
            u32x4 gw[2];
#pragma unroll
            for (int ni = 0; ni < 4; ni += 2) { const u32x4 t_ = *(const u32x4*)(P + ((size_t)rt * TR + wr * (TR / 2) + mi * 16 + fr) * DINP + C_PM + ct * 128 + wc * 64 + widen_col(ni, lane)); gw[ni >> 1] = widen_pair(lo2(t_), hi2(t_), lane); }
#pragma unroll
            for (int ni = 0; ni < 4; ++ni) {
                const u32x2 g = (ni & 1) ? hi2(gw[ni >> 1]) : lo2(gw[ni >> 1]);
                f32x4 s; s[0] = sigmoidf_(bf2f((bf16_t)(g.x & 0xffff))); s[1] = sigmoidf_(bf2f((bf16_t)(g.x >> 16))); s[2] = sigmoidf_(bf2f((bf16_t)(g.y & 0xffff))); s[3] = sigmoidf_(bf2f((bf16_t)(g.y >> 16)));
                t1[mi][ni] = pack4(acc[mi][ni] * s);
            }
        }
        acc_zero(acc);
        gemm_main<false>(acc, ss, RowsPlain{(const bf16_t*)(ws + WS_HM) + (size_t)rt * TR * 512, 512}, W + (size_t)ct * 128 * 1024 + 512, 1024, 512, smem);
#pragma unroll
        for (int mi = 0; mi < MIT; ++mi) {
            u32x4 gw[2];
#pragma unroll
            for (int ni = 0; ni < 4; ni += 2) { const u32x4 t_ = *(const u32x4*)(P + ((size_t)rt * TR + wr * (TR / 2) + mi * 16 + fr) * DINP + C_PM + 1024 + ct * 128 + wc * 64 + widen_col(ni, lane)); gw[ni >> 1] = widen_pair(lo2(t_), hi2(t_), lane); }
#pragma unroll
            for (int ni = 0; ni < 4; ++ni) {
                const u32x2 g = (ni & 1) ? hi2(gw[ni >> 1]) : lo2(gw[ni >> 1]);
                f32x4 s; s[0] = sigmoidf_(bf2f((bf16_t)(g.x & 0xffff))); s[1] = sigmoidf_(bf2f((bf16_t)(g.x >> 16))); s[2] = sigmoidf_(bf2f((bf16_t)(g.y & 0xffff))); s[3] = sigmoidf_(bf2f((bf16_t)(g.y >> 16)));
                f32x4 tv; tv[0] = bf2f((bf16_t)(t1[mi][ni].x & 0xffff)); tv[1] = bf2f((bf16_t)(t1[mi][ni].x >> 16)); tv[2] = bf2f((bf16_t)(t1[mi][ni].y & 0xffff)); tv[3] = bf2f((bf16_t)(t1[mi][ni].y >> 16));
                t1[mi][ni] = pack4(tv + acc[mi][ni] * s);
            }
        }
#pragma unroll
        for (int mi = 0; mi < MIT; ++mi)
#pragma unroll
            for (int ni = 0; ni < 4; ni += 2)
                *(u32x4*)(U + ((size_t)rt * TR + wr * (TR / 2) + mi * 16 + fr) * 1024 + ct * 128 + wc * 64 + widen_col(ni, lane)) = widen_pair(t1[mi][ni], t1[mi][ni + 1], lane);
    }
    convert_experts(p, l, NCV_D, NCV_E, smem, false);
}

DI void phase_f(const Params& p, int l, unsigned char* smem, int dry = 0) {
    unsigned char* ws = optr(p.ws); const int tid_ = otid(), lane = tid_ & 63, wave = tid_ >> 6, wr = wave >> 1, wc = wave & 1, fr = lane & 15, fq = lane >> 4;
    const bf16_t* W = (const bf16_t*)(ws + WS_WOUT) + (size_t)l * 1024 * 1024; const bf16_t* X = (const bf16_t*)(ws + WS_X); const float* MOD = (const float*)(ws + WS_MOD);
    const bool last = (l == DEPTH - 1);
    int rt, ct; bool have = xcd_unit(0, RTT, 8, rt, ct), pre = false;
    for (int it = 0; have; ++it) {
        int nrt = 0, nct = 0; const bool hn = xcd_unit(it + 1, RTT, 8, nrt, nct);
        const bool skip = last && (rt + 1) * TR <= CTX, nskip = last && (nrt + 1) * TR <= CTX, chain = hn && !nskip;
        if (skip) { rt = nrt; ct = nct; have = hn; pre = false; continue; }
        f32x4 acc[MIT][4]; acc_zero(acc);
        gemm_chain(acc, RowsPlain{(const bf16_t*)(ws + WS_U) + (size_t)rt * TR * 1024, 1024}, W + (size_t)ct * 128 * 1024, 1024, 1024, smem, pre, chain, RowsPlain{(const bf16_t*)(ws + WS_U) + (size_t)nrt * TR * 1024, 1024}, W + (size_t)nct * 128 * 1024, 1024);
#pragma unroll
        for (int mi = 0; mi < MIT; ++mi)
            {
                const size_t row = (size_t)rt * TR + wr * (TR / 2) + mi * 16 + fr;
                const float* g1 = MOD + ((size_t)l * 2 + (row < (size_t)CTX ? 1 : 0)) * 6144 + 2 * 1024;
                u32x2 zp[4]; u32x4 xw[2];
#pragma unroll
                for (int ni = 0; ni < 4; ni += 2) { const u32x4 t_ = *(const u32x4*)(X + row * 1024 + ct * 128 + wc * 64 + widen_col(ni, lane)); xw[ni >> 1] = widen_pair(lo2(t_), hi2(t_), lane); }
#pragma unroll
                for (int ni = 0; ni < 4; ++ni) {
                    const int c = ct * 128 + wc * 64 + ni * 16 + 4 * fq;
                    const f32x4 xv = unpack4h((ni & 1) ? hi2(xw[ni >> 1]) : lo2(xw[ni >> 1])), g = *(const f32x4*)(g1 + c);
                    zp[ni] = pack4h(xv * ALPHA + g * acc[mi][ni]);
                }
                bf16_t* zo = (bf16_t*)(ws + WS_ZB + (dry ? (size_t)T * 2048 : 0)) + row * 1024 + ct * 128 + wc * 64;
#pragma unroll
                for (int ni = 0; ni < 4; ni += 2) *(u32x4*)(zo + widen_col(ni, lane)) = widen_pair(zp[ni], zp[ni + 1], lane);
            }
        rt = nrt; ct = nct; have = hn; pre = chain;
    }
    if (!dry) convert_experts(p, l, NCV_E, NCV, smem, false);
}

DI void moe_offsets(const unsigned* cnt, int* s_nt, int* s_off, int* s_pre, int per_tile_units) {
    if (threadIdx.x == 0) {
        int off = 0, pre = 0;
        for (int e = 0; e < 32; ++e) { const int n = (int)cnt[e * 64], nt = (n + TH - 1) / TH; s_nt[e] = nt; s_off[e] = off; s_pre[e] = pre; off += nt * TH; pre += nt * per_tile_units; }
        s_pre[32] = pre;
    }
    __syncthreads();
}
DI void phase_h1(const Params& p, int l, unsigned char* smem) {
    unsigned char* ws = optr(p.ws); const int tid_ = otid(), lane = tid_ & 63, wave = tid_ >> 6, wr = wave >> 1, wc = wave & 1, fr = lane & 15, fq = lane >> 4;
    const unsigned* cnt = (const unsigned*)(ws + WS_CNT) + l * 4096; const int* LIST = (const int*)(ws + WS_LIST); const float* LISTW = (const float*)(ws + WS_LISTW);
    int* s_nt = (int*)(smem + LDS_BYTES); int* s_off = s_nt + 32; int* s_pre = s_off + 32;
    moe_offsets(cnt, s_nt, s_off, s_pre, 4);
    const int total = s_pre[32];
    for (int u = blockIdx.x; u < total; u += gridDim.x) {
        int e = 0; while (u >= s_pre[e + 1]) ++e;
        const int v = u - s_pre[e], rt = v >> 2, ct = v & 3, n = (int)cnt[e * 64] - rt * TH;
        f32x4 acc[MIH][4]; float ss[4]; acc_zero(acc);
        gemm_main<false>(acc, ss, RowsGather{(const bf16_t*)(ws + WS_HN), LIST + (size_t)e * T + rt * TH, n}, (const bf16_t*)(ws + WS_WGU) + ((size_t)e * 512 + ct * 128) * 1024, 1024, 1024, smem);
        bf16_t* HID = (bf16_t*)(ws + WS_HID) + (size_t)(s_off[e] + rt * TH) * 256;
#pragma unroll
        for (int mi = 0; mi < MIH; ++mi) {
            const int r = wr * (TH / 2) + mi * 16 + fr;
            const float w = (r < n) ? LISTW[(size_t)e * T + rt * TH + r] : 0.f;
            u32x2 hp[2];
#pragma unroll
            for (int ni = 0; ni < 4; ni += 2) {
                const f32x4 a = acc[mi][ni], b = acc[mi][ni + 1]; f32x4 hd;
#pragma unroll
                for (int j = 0; j < 4; ++j) hd[j] = siluf_(a[j]) * b[j] * w;
                hp[ni >> 1] = pack4(hd);
            }
            const u32x4 hw = widen_pair(hp[0], hp[1], lane);
            if (r < n) *(u32x4*)(HID + (size_t)r * 256 + ct * 64 + wc * 32 + widen_col(0, lane)) = hw;
        }
    }
}
DI void phase_h2(const Params& p, int l, unsigned char* smem) {
    unsigned char* ws = optr(p.ws); const int tid_ = otid(), lane = tid_ & 63, wave = tid_ >> 6, wr = wave >> 1, wc = wave & 1, fr = lane & 15, fq = lane >> 4;
    const unsigned* cnt = (const unsigned*)(ws + WS_CNT) + l * 4096; const int* LIST = (const int*)(ws + WS_LIST);
    int* s_nt = (int*)(smem + LDS_BYTES); int* s_off = s_nt + 32; int* s_pre = s_off + 32;
    moe_offsets(cnt, s_nt, s_off, s_pre, 8);
    const int total = s_pre[32];
    bf16_t* MOE = (bf16_t*)(ws + WS_MOE);
    for (int u = blockIdx.x; u < total; u += gridDim.x) {
        int e = 0; while (u >= s_pre[e + 1]) ++e;
        const int v = u - s_pre[e], rt = v >> 3, ct = v & 7, n = (int)cnt[e * 64] - rt * TH;
        f32x4 acc[MIH][4]; float ss[4]; acc_zero(acc);
        gemm_main<false>(acc, ss, RowsPlain{(const bf16_t*)(ws + WS_HID) + (size_t)(s_off[e] + rt * TH) * 256, 256}, (const bf16_t*)(ws + WS_WD) + ((size_t)e * 1024 + ct * 128) * 256, 256, 256, smem);
#pragma unroll
        for (int mi = 0; mi < MIH; ++mi) {
            const int r = wr * (TH / 2) + mi * 16 + fr;
            const u32x4 w0 = widen_pair(pack4(acc[mi][0]), pack4(acc[mi][1]), lane), w1 = widen_pair(pack4(acc[mi][2]), pack4(acc[mi][3]), lane);
            if (r < n) {
                const int ent = LIST[(size_t)e * T + rt * TH + r];
                bf16_t* dst = MOE + (size_t)ent * 1024 + ct * 128 + wc * 64;
                *(u32x4*)(dst + widen_col(0, lane)) = w0; *(u32x4*)(dst + widen_col(2, lane)) = w1;
            }
        }
    }
}

#ifndef EMU
#define GRID_SYNC() xcd_barrier(bar)
#else
#define GRID_SYNC() emu::grid_sync()
#endif
#ifndef PHASE_MASK
#define PHASE_MASK 0xFFF
#endif
#define PH_IN(ph) ((ph) >= p.ph_lo && (ph) < p.ph_hi)
#define PH_ON(k) ((PHASE_MASK >> (k)) & 1)

#define PH_SEAM(ph) do { if (PH_IN(ph) && (ph) + 1 < p.ph_hi) { GRID_SYNC(); if (PROBE_DUP == 20) GRID_SYNC(); } } while (0)

__global__ void __launch_bounds__(NTHREADS, 2) mega_fwd(Params p) {
    SMEM_DECL
#ifndef EMU
    if (threadIdx.x == 0) *(uint4*)(smem + LDS_BYTES + 512) = make_uint4(0u, 0u, 0u, 0u);
    __syncthreads();
    XcdBarrier bar = xcd_barrier_post((unsigned*)(p.ws + WS_BAR), (volatile LAS unsigned*)(smem + LDS_BYTES + 512));
#endif
    if (PH_ON(10) && PH_IN(0)) { phase_p0(p, smem); if (PROBE_DUP == 10) { __syncthreads(); phase_p0(p, smem); } }
    PH_SEAM(0);
    if (PH_ON(11) && PH_IN(1)) phase_p1(p);
    PH_SEAM(1);
    for (int l = 0; l < DEPTH; ++l) {
        const int b = 2 + l * NPH;
        if (b + NPH <= p.ph_lo || b >= p.ph_hi) continue;
        if (PH_ON(0) && PH_IN(b + 0)) { phase_a(p, l, smem); if (PROBE_DUP == 0) { __syncthreads(); phase_a(p, l, smem); } }
        PH_SEAM(b + 0);
        if (PH_ON(1) && PH_IN(b + 1)) { phase_b(p, l, smem); if (PROBE_DUP == 1) { __syncthreads(); phase_b(p, l, smem); } }
        PH_SEAM(b + 1);
        if (PH_ON(2) && PH_IN(b + 2)) { phase_c(p, smem); if (PROBE_DUP == 2) { __syncthreads(); phase_c(p, smem); } }
        PH_SEAM(b + 2);
        if (PH_ON(3) && PH_IN(b + 3)) { phase_d(p, l, smem); if (PROBE_DUP == 3) { __syncthreads(); phase_d(p, l, smem); } }
        PH_SEAM(b + 3);
        if (PH_ON(4) && PH_IN(b + 4)) { phase_e(p, l, smem); if (PROBE_DUP == 4) { __syncthreads(); phase_e(p, l, smem); } }
        PH_SEAM(b + 4);
        if (PH_ON(5) && PH_IN(b + 5)) { if (PROBE_DUP == 5) { phase_f(p, l, smem, 1); __syncthreads(); } phase_f(p, l, smem); }
        PH_SEAM(b + 5);
        if (PH_ON(6) && PH_IN(b + 6)) { if (PROBE_DUP == 6) { phase_g(p, l, smem, 1); __syncthreads(); } if (PROBE_DUP == 62) { phase_g(p, l, smem, 2); __syncthreads(); } if (PROBE_DUP == 63) { phase_g(p, l, smem, 3); __syncthreads(); } phase_g(p, l, smem); }
        PH_SEAM(b + 6);
        if (PH_ON(7) && PH_IN(b + 7)) { phase_h1(p, l, smem); if (PROBE_DUP == 7) { __syncthreads(); phase_h1(p, l, smem); } }
        PH_SEAM(b + 7);
        if (PH_ON(8) && PH_IN(b + 8)) { phase_h2(p, l, smem); if (PROBE_DUP == 8) { __syncthreads(); phase_h2(p, l, smem); } }
        PH_SEAM(b + 8);
        if (PH_ON(9) && PH_IN(b + 9)) { if (PROBE_DUP == 9) { phase_i(p, l, 1); __syncthreads(); } phase_i(p, l); }
        PH_SEAM(b + 9);
    }
}

extern "C" void kernel_launch(void* const* d_in, const int* in_sizes, int n_in, void* d_out, int out_size, void* d_ws, size_t ws_size, hipStream_t stream) {
    Params p;
    memset(&p, 0, sizeof(p));
    const float** f = (const float**)&p;
    for (int i = 0; i < 28; ++i) f[i] = (const float*)d_in[i];
    p.out = (float*)d_out; p.ws = (unsigned char*)d_ws;
    constexpr int LDS_TOTAL = LDS_BYTES + 1024;
#ifndef EMU
    static int grid = 0;
    if (grid == 0) {
        if (n_in != 28 || ws_size < WS_END) { fprintf(stderr, "kernel_launch: need 28 inputs and %zu bytes of workspace (got %d, %zu)\n", (size_t)WS_END, n_in, ws_size); grid = -1; return; }
        int dev = 0, cus = 0, per_cu = 0;
        hipGetDevice(&dev); hipDeviceGetAttribute(&cus, hipDeviceAttributeMultiprocessorCount, dev);
        if (hipFuncSetAttribute((const void*)mega_fwd, hipFuncAttributeMaxDynamicSharedMemorySize, LDS_TOTAL) != hipSuccess) { fprintf(stderr, "kernel_launch: hipFuncSetAttribute failed\n"); grid = -1; return; }
        if (hipOccupancyMaxActiveBlocksPerMultiprocessor(&per_cu, (const void*)mega_fwd, NTHREADS, LDS_TOTAL) != hipSuccess || per_cu < 1) per_cu = 1;
        (void)hipGetLastError();
        grid = cus * (per_cu < 2 ? per_cu : 2);
    }
    if (grid < 0) return;
    hipMemsetAsync((char*)d_ws + WS_BAR, 0, WS_ZERO_BYTES, stream);
#if N_LAUNCH_MODE == 0
    p.ph_lo = 0; p.ph_hi = NPHASE_TOTAL;
    hipLaunchKernelGGL(mega_fwd, dim3(grid), dim3(NTHREADS), LDS_TOTAL, stream, p);
#else
    for (int ph = 0; ph < NPHASE_TOTAL; ++ph) { p.ph_lo = ph; p.ph_hi = ph + 1; hipLaunchKernelGGL(mega_fwd, dim3(grid), dim3(NTHREADS), LDS_TOTAL, stream, p); }
#endif
#else
    if (ws_size < WS_END) { fprintf(stderr, "EMU: workspace too small: need %zu\n", (size_t)WS_END); exit(1); }
    if (emu_ph_lo == 0) memset((char*)d_ws + WS_BAR, 0, WS_ZERO_BYTES);
    if (emu_one_launch) { p.ph_lo = emu_ph_lo; p.ph_hi = emu_ph_hi; emu::launch([p]() { mega_fwd(p); }, emu_grid, NTHREADS, LDS_TOTAL, true); }
    else for (int ph = emu_ph_lo; ph < emu_ph_hi; ++ph) { p.ph_lo = ph; p.ph_hi = ph + 1; fprintf(stderr, "EMU phase %d\n", ph); emu::launch([p]() { mega_fwd(p); }, emu_grid, NTHREADS, LDS_TOTAL, false); }
#endif
}
```
